# Optimizing an MI355X kernel written in HIP

```python
import math
import jax
import jax.numpy as jnp
from jax import lax
import numpy as np

D_MODEL = 1024
BATCH = 2
SEQ = 16384
DEPTH = 2

GRID_W = 64
CTX_LEN = 256
EPS = 1e-6
N_MOD = 6

POOL_GROUPS = 4
POOL_GDIM = D_MODEL // 16
POOL_DIM = POOL_GROUPS * POOL_GDIM
POOL_WINDOWS = (2, 4, 8, 16)

SSD_HEADS = 4
SSD_HEAD_DIM = 64
SSD_INNER = SSD_HEADS * SSD_HEAD_DIM
SSD_GROUPS = 2
SSD_STATE = 64
SSD_CONV = 5
SSD_CHUNK = 128
SSD_DIRS = 2
SSD_XBC = SSD_INNER + 2 * SSD_GROUPS * SSD_STATE
SSD_PROJ = SSD_INNER + SSD_XBC + SSD_DIRS * SSD_HEADS

ATTN_HEADS = 4
ATTN_KV_HEADS = 2
HEAD_DIM = 128
ATTN_REP = ATTN_HEADS // ATTN_KV_HEADS
ATTN_DIM = ATTN_HEADS * HEAD_DIM
KV_DIM = ATTN_KV_HEADS * HEAD_DIM
ATTN_PROJ = ATTN_DIM + 2 * KV_DIM
Q_BLOCK = 128
ROPE_THETA = 10000.0

D_MIX = POOL_DIM + SSD_INNER + ATTN_DIM
D_IN = POOL_DIM + SSD_PROJ + ATTN_PROJ
D_FF = -(-(8 * D_MODEL) // (3 * 256)) * 256

kernel_name = 'hybrid_pool_ssd_gqa_dit_block'


def rmsnorm(x, w):
    xf = x.astype(jnp.float32)
    xf = xf * lax.rsqrt(jnp.mean(xf * xf, axis=-1, keepdims=True) + EPS)
    return xf.astype(x.dtype) * w


def modulation(cond, w_mod, b_mod):
    m = jax.nn.silu(cond) @ w_mod + b_mod
    return [t[:, None, :] for t in jnp.split(m, N_MOD, axis=-1)]


def adaln(h, w, shift, scale):
    return rmsnorm(h, w) * (1 + scale) + shift


def centred_mean_minus_self(u, w):
    L = u.shape[1]
    cs = jnp.cumsum(u.astype(jnp.float32), axis=1)
    cs = jnp.concatenate([jnp.zeros_like(cs[:, :1]), cs], axis=1)
    t = jnp.arange(L)
    lo = jnp.clip(t - w // 2, 0, L)
    hi = jnp.clip(t - w // 2 + w, 0, L)
    cnt = (hi - lo).astype(jnp.float32)[None, :, None]
    mean = (jnp.take(cs, hi, axis=1) - jnp.take(cs, lo, axis=1)) / cnt
    return mean.astype(u.dtype) - u


def pool_mixer(u, pool_w, pool_scale):
    Bsz, L, _ = u.shape
    ug = u.reshape(Bsz, L, POOL_GROUPS, POOL_GDIM)
    pooled = jnp.stack([centred_mean_minus_self(ug[:, :, g], w) for g, w in enumerate(POOL_WINDOWS)], axis=2)
    out = jnp.einsum('blgc,gcd->blgd', pooled, pool_w).reshape(Bsz, L, POOL_DIM)
    return out * pool_scale


def dwconv_centred(u, w, b):
    pad = w.shape[0] // 2
    out = lax.conv_general_dilated(u, w[:, None, :].astype(u.dtype), window_strides=(1,),
                                   padding=[(pad, pad)], dimension_numbers=('NWC', 'WIO', 'NWC'),
                                   feature_group_count=u.shape[-1])
    return out + b


def ssd_prep(u, conv_w, conv_b):
    Bsz, L, _ = u.shape
    z = u[..., :SSD_INNER]
    xbc = jax.nn.silu(dwconv_centred(u[..., SSD_INNER:SSD_INNER + SSD_XBC], conv_w, conv_b))
    xh = xbc[..., :SSD_INNER].reshape(Bsz, L, SSD_HEADS, SSD_HEAD_DIM)
    bc = xbc[..., SSD_INNER:].reshape(Bsz, L, 2, SSD_GROUPS, SSD_STATE)
    rep = SSD_HEADS // SSD_GROUPS
    Bm = jnp.repeat(bc[:, :, 0], rep, axis=2)
    Cm = jnp.repeat(bc[:, :, 1], rep, axis=2)
    dt_raw = u[..., SSD_INNER + SSD_XBC:].reshape(Bsz, L, SSD_DIRS, SSD_HEADS)
    return z, xh, Bm, Cm, dt_raw


def segsum(a):
    T = a.shape[-1]
    cs = jnp.cumsum(a, axis=-1)
    diff = cs[..., :, None] - cs[..., None, :]
    mask = jnp.tril(jnp.ones((T, T), dtype=bool))
    return jnp.where(mask, diff, -jnp.inf)


def ssd_scan(xh, dt, A, Bm, Cm, h0, with_output):
    Bsz, L, H, P = xh.shape
    N = Bm.shape[-1]
    nc = L // SSD_CHUNK
    x = (xh * dt[..., None]).reshape(Bsz, nc, SSD_CHUNK, H, P)
    a = (dt * A).reshape(Bsz, nc, SSD_CHUNK, H).transpose(0, 3, 1, 2)
    Bc = Bm.reshape(Bsz, nc, SSD_CHUNK, H, N)
    Cc = Cm.reshape(Bsz, nc, SSD_CHUNK, H, N)
    a_cs = jnp.cumsum(a, axis=-1)
    decay_states = jnp.exp(a_cs[..., -1:] - a_cs)
    states = jnp.einsum('bclhn,bhcl,bclhp->bchpn', Bc, decay_states, x)
    states = jnp.concatenate([h0[:, None].astype(states.dtype), states], axis=1)
    chunk_decay = jnp.exp(segsum(jnp.pad(a_cs[..., -1], ((0, 0), (0, 0), (1, 0)))))
    new_states = jnp.einsum('bhzc,bchpn->bzhpn', chunk_decay, states)
    prev_states, final = new_states[:, :-1], new_states[:, -1]
    if not with_output:
        return None, final
    Lmat = jnp.exp(segsum(a))
    scores = jnp.einsum('bclhn,bcshn->bhcls', Cc, Bc) * Lmat
    y_diag = jnp.einsum('bhcls,bcshp->bclhp', scores, x)
    y_off = jnp.einsum('bclhn,bchpn,bhcl->bclhp', Cc, prev_states, jnp.exp(a_cs))
    return (y_diag + y_off).reshape(Bsz, L, H, P), final


def gated_rmsnorm(y, z, w):
    Bsz, L = y.shape[:2]
    g = (y.reshape(Bsz, L, SSD_INNER) * jax.nn.silu(z.astype(jnp.float32))).reshape(Bsz, L, SSD_GROUPS, -1)
    g = g * lax.rsqrt(jnp.mean(g * g, axis=-1, keepdims=True) + EPS)
    return g.reshape(Bsz, L, SSD_INNER).astype(z.dtype) * w


def ssd_bidirectional(pc, px, dt_bias, a_log, d_skip, ssd_norm_w, need_ctx):
    zc, xc, Bc, Cc, dtc = pc
    zx, xx, Bx, Cx, dtx = px
    Bsz = xx.shape[0]
    y_x = jnp.zeros(xx.shape, jnp.float32)
    y_c = jnp.zeros(xc.shape, jnp.float32)
    for d in range(SSD_DIRS):
        flip = (lambda t: jnp.flip(t, axis=1)) if d == 1 else (lambda t: t)
        A = -jnp.exp(a_log[d].astype(jnp.float32))
        dt_c = jax.nn.softplus(dtc[:, :, d].astype(jnp.float32) + dt_bias[d])
        dt_x = jax.nn.softplus(dtx[:, :, d].astype(jnp.float32) + dt_bias[d])
        h0 = jnp.zeros((Bsz, SSD_HEADS, SSD_HEAD_DIM, SSD_STATE), jnp.float32)
        yc_d, hc = ssd_scan(flip(xc), flip(dt_c), A, flip(Bc), flip(Cc), h0, need_ctx)
        yx_d, _ = ssd_scan(flip(xx), flip(dt_x), A, flip(Bx), flip(Cx), hc, True)
        y_x = y_x + flip(yx_d) + d_skip[d][:, None] * xx
        if need_ctx:
            y_c = y_c + flip(yc_d) + d_skip[d][:, None] * xc
    out_x = gated_rmsnorm(y_x, zx, ssd_norm_w)
    out_c = gated_rmsnorm(y_c, zc, ssd_norm_w) if need_ctx else None
    return out_c, out_x


def axial_rope_tables(L):
    rows = L // GRID_W
    row_ids = jnp.repeat(jnp.arange(rows, dtype=jnp.float32), GRID_W)
    col_ids = jnp.tile(jnp.arange(GRID_W, dtype=jnp.float32), rows)
    axis_dim = HEAD_DIM // 2
    inv_freq = ROPE_THETA ** (-jnp.arange(0, axis_dim, 2, dtype=jnp.float32) / axis_dim)
    ang_r = row_ids[:, None] * inv_freq[None, :]
    ang_c = col_ids[:, None] * inv_freq[None, :]
    return jnp.cos(ang_r), jnp.sin(ang_r), jnp.cos(ang_c), jnp.sin(ang_c)


def rope_half(x, cos, sin):
    m = x.shape[-1] // 2
    x1, x2 = x[..., :m], x[..., m:]
    cos = cos[:, None, :].astype(x.dtype)
    sin = sin[:, None, :].astype(x.dtype)
    return jnp.concatenate([x1 * cos - x2 * sin, x1 * sin + x2 * cos], axis=-1)


def apply_axial_rope(x, tables):
    cr, sr, cc, sc = tables
    h = HEAD_DIM // 2
    return jnp.concatenate([rope_half(x[..., :h], cr, sr), rope_half(x[..., h:], cc, sc)], axis=-1)


def attn_split(u, q_norm_w, k_norm_w):
    Bsz, L, _ = u.shape
    q = rmsnorm(u[..., :ATTN_DIM].reshape(Bsz, L, ATTN_HEADS, HEAD_DIM), q_norm_w)
    k = rmsnorm(u[..., ATTN_DIM:ATTN_DIM + KV_DIM].reshape(Bsz, L, ATTN_KV_HEADS, HEAD_DIM), k_norm_w)
    v = u[..., ATTN_DIM + KV_DIM:].reshape(Bsz, L, ATTN_KV_HEADS, HEAD_DIM)
    return q, k, v


def gqa_attend(qblk, k, v):
    s = jnp.einsum('bqgrd,bkgd->bgrqk', qblk, k).astype(jnp.float32) * (HEAD_DIM ** -0.5)
    p = jax.nn.softmax(s, axis=-1).astype(v.dtype)
    return jnp.einsum('bgrqk,bkgd->bqgrd', p, v)


def latent_attention(q, k_all, v_all):
    Bsz, L = q.shape[:2]
    nb = L // Q_BLOCK
    qb = q.reshape(Bsz, nb, Q_BLOCK, ATTN_KV_HEADS, ATTN_REP, HEAD_DIM).transpose(1, 0, 2, 3, 4, 5)
    out = lax.map(lambda qblk: gqa_attend(qblk, k_all, v_all), qb)
    return out.transpose(1, 0, 2, 3, 4, 5).reshape(Bsz, L, ATTN_DIM)


def context_attention(q, k, v):
    Bsz, L = q.shape[:2]
    qg = q.reshape(Bsz, L, ATTN_KV_HEADS, ATTN_REP, HEAD_DIM)
    return gqa_attend(qg, k, v).reshape(Bsz, L, ATTN_DIM)


def swiglu(h, w1, w3, w2):
    return (jax.nn.silu(h @ w1) * (h @ w3)) @ w2


def hybrid_layer(xs, cs, c, c_ctx, norm1_w, norm2_w, w_mod, b_mod, w_in, pool_w, pool_scale,
                 conv_w, conv_b, dt_bias, a_log, d_skip, ssd_norm_w, q_norm_w, k_norm_w,
                 w_out, w1, w3, w2, rope, need_ctx):
    sh1x, sc1x, g1x, sh2x, sc2x, g2x = modulation(c, w_mod, b_mod)
    sh1c, sc1c, g1c, sh2c, sc2c, g2c = modulation(c_ctx[None, :], w_mod, b_mod)
    ux = adaln(xs, norm1_w, sh1x, sc1x) @ w_in
    uc = adaln(cs, norm1_w, sh1c, sc1c) @ w_in
    o_ssd, o_att = POOL_DIM, POOL_DIM + SSD_PROJ

    pool_x = pool_mixer(ux[..., :o_ssd], pool_w, pool_scale)
    ssd_c, ssd_x = ssd_bidirectional(ssd_prep(uc[..., o_ssd:o_att], conv_w, conv_b),
                                     ssd_prep(ux[..., o_ssd:o_att], conv_w, conv_b),
                                     dt_bias, a_log, d_skip, ssd_norm_w, need_ctx)
    qx, kx, vx = attn_split(ux[..., o_att:], q_norm_w, k_norm_w)
    qc, kc, vc = attn_split(uc[..., o_att:], q_norm_w, k_norm_w)
    qx = apply_axial_rope(qx, rope)
    kx = apply_axial_rope(kx, rope)
    attn_x = latent_attention(qx, jnp.concatenate([kc, kx], axis=1), jnp.concatenate([vc, vx], axis=1))

    mix_x = jnp.concatenate([pool_x, ssd_x.astype(xs.dtype), attn_x], axis=-1) @ w_out
    xs = xs + g1x * mix_x
    xs = xs + g2x * swiglu(adaln(xs, norm2_w, sh2x, sc2x), w1, w3, w2)

    if need_ctx:
        pool_c = pool_mixer(uc[..., :o_ssd], pool_w, pool_scale)
        attn_c = context_attention(qc, kc, vc)
        mix_c = jnp.concatenate([pool_c, ssd_c.astype(cs.dtype), attn_c], axis=-1) @ w_out
        cs = cs + g1c * mix_c
        cs = cs + g2c * swiglu(adaln(cs, norm2_w, sh2c, sc2c), w1, w3, w2)
    return xs, cs


def setup_inputs(seed: int = 0) -> dict:
    key = jax.random.key(seed)
    ks = jax.random.split(key, 24)
    f32 = jnp.float32

    def nrm(k, shape, scale):
        return jax.random.normal(k, shape, f32) * scale

    dt0 = jnp.exp(jax.random.uniform(ks[13], (DEPTH, SSD_DIRS, SSD_HEADS), f32, math.log(1e-3), math.log(1e-1)))
    return {
        'x': nrm(ks[0], (BATCH, SEQ, D_MODEL), 1.0),
        'c': nrm(ks[1], (BATCH, D_MODEL), 1.0),
        'ctx': nrm(ks[2], (BATCH, CTX_LEN, D_MODEL), 1.0),
        'c_ctx': nrm(ks[3], (D_MODEL,), 1.0),
        'norm1_w': 1.0 + nrm(ks[4], (DEPTH, D_MODEL), 0.05),
        'norm2_w': 1.0 + nrm(ks[5], (DEPTH, D_MODEL), 0.05),
        'w_mod': nrm(ks[6], (DEPTH, D_MODEL, N_MOD * D_MODEL), 0.5 * D_MODEL ** -0.5),
        'b_mod': nrm(ks[7], (DEPTH, N_MOD * D_MODEL), 0.02),
        'w_in': nrm(ks[8], (DEPTH, D_MODEL, D_IN), D_MODEL ** -0.5),
        'pool_w': nrm(ks[9], (DEPTH, POOL_GROUPS, POOL_GDIM, POOL_GDIM), POOL_GDIM ** -0.5),
        'pool_scale': 1.0 + nrm(ks[10], (DEPTH, POOL_DIM), 0.1),
        'conv_w': nrm(ks[11], (DEPTH, SSD_CONV, SSD_XBC), SSD_CONV ** -0.5),
        'conv_b': nrm(ks[12], (DEPTH, SSD_XBC), 0.02),
        'dt_bias': dt0 + jnp.log(-jnp.expm1(-dt0)),
        'a_log': jnp.log(jax.random.uniform(ks[14], (DEPTH, SSD_DIRS, SSD_HEADS), f32, 1.0, 16.0)),
        'd_skip': 1.0 + nrm(ks[15], (DEPTH, SSD_DIRS, SSD_HEADS), 0.1),
        'ssd_norm_w': 1.0 + nrm(ks[16], (DEPTH, SSD_INNER), 0.05),
        'q_norm_w': 1.0 + nrm(ks[17], (DEPTH, HEAD_DIM), 0.05),
        'k_norm_w': 1.0 + nrm(ks[18], (DEPTH, HEAD_DIM), 0.05),
        'w_out': nrm(ks[19], (DEPTH, D_MIX, D_MODEL), D_MIX ** -0.5),
        'w1': nrm(ks[20], (DEPTH, D_MODEL, D_FF), D_MODEL ** -0.5),
        'w3': nrm(ks[21], (DEPTH, D_MODEL, D_FF), D_MODEL ** -0.5),
        'w2': nrm(ks[22], (DEPTH, D_FF, D_MODEL), D_FF ** -0.5),
    }


def reference(x, c, ctx, c_ctx, norm1_w, norm2_w, w_mod, b_mod, w_in, pool_w, pool_scale,
              conv_w, conv_b, dt_bias, a_log, d_skip, ssd_norm_w, q_norm_w, k_norm_w,
              w_out, w1, w3, w2):
    rope = axial_rope_tables(x.shape[1])
    xs, cs = x, ctx
    for layer in range(DEPTH):
        xs, cs = hybrid_layer(xs, cs, c, c_ctx, norm1_w[layer], norm2_w[layer], w_mod[layer], b_mod[layer],
                              w_in[layer], pool_w[layer], pool_scale[layer], conv_w[layer], conv_b[layer],
                              dt_bias[layer], a_log[layer], d_skip[layer], ssd_norm_w[layer],
                              q_norm_w[layer], k_norm_w[layer], w_out[layer], w1[layer], w3[layer], w2[layer],
                              rope, need_ctx=(layer < DEPTH - 1))
    return xs
```

```cpp
#include <hip/hip_runtime.h>
#include <hip/hip_bf16.h>
#include <hip/hip_cooperative_groups.h>
#include <cstdio>
#include <cstdint>
namespace cg = cooperative_groups;


namespace pg8 {
#define PG8_LAS __attribute__((address_space(3)))
typedef unsigned short bf16_t;
typedef short bf16x8 __attribute__((ext_vector_type(8)));
typedef float f32x4 __attribute__((ext_vector_type(4)));
typedef unsigned u32x4 __attribute__((ext_vector_type(4)));
constexpr int BM = 256, BK = 64, HALF = 128, HTB = HALF * BK * 2  , STAGE_BYTES = 8 * HTB, NXCD = 8, WGM = 8;

__host__ __device__ __forceinline__ int lds_byte(int r, int c) { const int st = (r >> 4) * 2 + (c >> 5), rr = r & 15, cc = c & 31, ob = rr * 64 + cc * 2; return st * 1024 + (ob ^ (((ob >> 9) & 1) << 5)); }
__host__ __device__ __forceinline__ void stage_rc(int b, int& R, int& C) { const int st = b / 1024, sb = b % 1024, swz = sb ^ (((sb >> 9) & 1) << 5); R = (st >> 1) * 16 + swz / 64; C = (st & 1) * 32 + (swz % 64) / 2; }
__host__ __device__ __forceinline__ int perm32(int rho) { const int n = rho >> 4, i = rho & 15; return 8 * (i >> 2) + 4 * n + (i & 3); }

struct Unit { int pm, pn; };
struct Gemm { const bf16_t* A; const bf16_t* Bt; int M, N, K; };

struct StaticOrder {
    int nM, nN, nwg, G, c;
    __host__ __device__ void init(int M, int N, int G_, int c_) { nM = M / BM; nN = N / BM; nwg = nM * nN; G = G_; c = c_; }
    __host__ __device__ bool next(int i, Unit& u) const {
        const long L = (long)i * G + c; if (L >= nwg) return false;
        int wgid = (int)L; { const int q = nwg / NXCD, r = nwg % NXCD, xcd = wgid % NXCD, off = wgid / NXCD; wgid = (xcd < r ? xcd * (q + 1) : r * (q + 1) + (xcd - r) * q) + off; }
        const int nig = WGM * nN, gid = wgid / nig, fm = gid * WGM, gsz = (nM - fm) < WGM ? (nM - fm) : WGM;
        u.pm = fm + ((wgid % nig) % gsz); u.pn = (wgid % nig) / gsz; return true;
    }
    __device__ __forceinline__ void a_ready(const Unit&) const {}
    __device__ __forceinline__ void done(const Unit&) const {}
};
__device__ __forceinline__ unsigned cvt_pk_bf16(float lo, float hi) { unsigned r; asm volatile("v_cvt_pk_bf16_f32 %0, %1, %2" : "=v"(r) : "v"(lo), "v"(hi)); return r; }
typedef float f32x2 __attribute__((ext_vector_type(2)));
struct OrderX {
    StaticOrder b; int skip;
    __device__ void init(int ntm, int N, int G_, int c_, int skip_) { b.init(ntm * BM, N, G_, c_); skip = skip_; }
    __device__ bool next(int i, Unit& u) const { if (!b.next(i, u)) return false; if (skip) u.pm = u.pm + 1 + (u.pm >> 6); return true; }
    __device__ __forceinline__ void a_ready(const Unit&) const {}
    __device__ __forceinline__ void done(const Unit&) const {}
};
struct EpiInProj {
    static constexpr bool PERM = true, AFTER_DRAIN = false;
    bf16_t* U; float* DT;
    __device__ __forceinline__ void operator()(const f32x4 (&acc)[2][2][4][2], const Unit& u, int wr, int wc, int fr, int fq) const {
        const int row0 = u.pm * BM + wr * 64 + fr;
        if (u.pn < 8) {
            const int col0 = u.pn * BM + wc * 32 + 8 * fq;
#pragma unroll
            for (int ai = 0; ai < 2; ++ai)
#pragma unroll
                for (int m = 0; m < 4; ++m) { bf16_t* rowp = U + (size_t)(row0 + ai * HALF + m * 16) * 2048 + col0;
#pragma unroll
                    for (int bj = 0; bj < 2; ++bj) { const f32x4 v0 = acc[ai][bj][m][0], v1 = acc[ai][bj][m][1];
                        u32x4 w; w.x = cvt_pk_bf16(v0[0], v0[1]); w.y = cvt_pk_bf16(v0[2], v0[3]); w.z = cvt_pk_bf16(v1[0], v1[1]); w.w = cvt_pk_bf16(v1[2], v1[3]);
                        *(u32x4*)(rowp + bj * HALF) = w; } }
        } else if (wc == 0 && fq == 0) {
#pragma unroll
            for (int ai = 0; ai < 2; ++ai)
#pragma unroll
                for (int m = 0; m < 4; ++m) { float* p = DT + (size_t)(row0 + ai * HALF + m * 16) * 8;
                    *(f32x4*)p = acc[ai][0][m][0]; *(f32x4*)(p + 4) = acc[ai][0][m][1]; }
        }
    }
};
__device__ __forceinline__ f32x4 ld4(const float* p) { return *(const f32x4*)p; }
__device__ __forceinline__ f32x4 ld4(const bf16_t* p) { const unsigned long long r = *(const unsigned long long*)p; const unsigned lo = (unsigned)r, hi = (unsigned)(r >> 32);
    return (f32x4){__uint_as_float(lo << 16), __uint_as_float(lo & 0xffff0000u), __uint_as_float(hi << 16), __uint_as_float(hi & 0xffff0000u)}; }
__device__ __forceinline__ void st4(float* p, f32x4 v) { *(f32x4*)p = v; }
__device__ __forceinline__ void st4(bf16_t* p, f32x4 v) { const unsigned long long w = (unsigned long long)cvt_pk_bf16(v[0], v[1]) | ((unsigned long long)cvt_pk_bf16(v[2], v[3]) << 32); *(unsigned long long*)p = w; }
__device__ __forceinline__ void ld8(const float* p, f32x4& a, f32x4& b) { a = *(const f32x4*)p; b = *(const f32x4*)(p + 4); }
__device__ __forceinline__ void ld8(const bf16_t* p, f32x4& a, f32x4& b) { const u32x4 r = *(const u32x4*)p;
    a = (f32x4){__uint_as_float(r.x << 16), __uint_as_float(r.x & 0xffff0000u), __uint_as_float(r.y << 16), __uint_as_float(r.y & 0xffff0000u)};
    b = (f32x4){__uint_as_float(r.z << 16), __uint_as_float(r.z & 0xffff0000u), __uint_as_float(r.w << 16), __uint_as_float(r.w & 0xffff0000u)}; }
__device__ __forceinline__ void st8(float* p, f32x4 a, f32x4 b) { *(f32x4*)p = a; *(f32x4*)(p + 4) = b; }
__device__ __forceinline__ void st8(bf16_t* p, f32x4 a, f32x4 b) { u32x4 w; w.x = cvt_pk_bf16(a[0], a[1]); w.y = cvt_pk_bf16(a[2], a[3]); w.z = cvt_pk_bf16(b[0], b[1]); w.w = cvt_pk_bf16(b[2], b[3]); *(u32x4*)p = w; }
template <class RT, class OT> struct EpiResid {
    static constexpr bool PERM = true, AFTER_DRAIN = false;
    const RT* res_lat; const RT* res_ctx; OT* out_lat; OT* out_ctx; const float* gate;
    __device__ __forceinline__ void operator()(const f32x4 (&acc)[2][2][4][2], const Unit& u, int wr, int wc, int fr, int fq) const {
        const int b = u.pm / 65, w = u.pm % 65;
        const RT* rb; OT* ob; const float* gp;
        if (w == 0) { rb = res_ctx + (size_t)b * 256 * 1024; ob = out_ctx + (size_t)b * 256 * 1024; gp = gate + 2 * 6144; }
        else { const size_t o = ((size_t)b * 16384 + (size_t)(w - 1) * 256) * 1024; rb = res_lat + o; ob = out_lat + o; gp = gate + b * 6144; }
        const int col0 = u.pn * BM + wc * 32 + 8 * fq;
        f32x4 gv[2][2];
#pragma unroll
        for (int bj = 0; bj < 2; ++bj)
#pragma unroll
            for (int n = 0; n < 2; ++n) gv[bj][n] = *(const f32x4*)(gp + col0 + bj * HALF + 4 * n);
#pragma unroll
        for (int ai = 0; ai < 2; ++ai)
#pragma unroll
            for (int m = 0; m < 4; ++m) { const size_t ro = (size_t)(wr * 64 + fr + ai * HALF + m * 16) * 1024 + col0;
#pragma unroll
                for (int bj = 0; bj < 2; ++bj) {
                    f32x4 r0, r1; ld8(rb + ro + bj * HALF, r0, r1);
                    st8(ob + ro + bj * HALF, r0 + gv[bj][0] * acc[ai][bj][m][0], r1 + gv[bj][1] * acc[ai][bj][m][1]); } }
    }
};
struct EpiSwiGLU {
    static constexpr bool PERM = true, AFTER_DRAIN = false;
    bf16_t* ACT;
    __device__ __forceinline__ static float sw(float g, float u) { return g * u * __builtin_amdgcn_rcpf(1.0f + __builtin_amdgcn_exp2f(-1.4426950408889634f * g)); }
    __device__ __forceinline__ void operator()(const f32x4 (&acc)[2][2][4][2], const Unit& u, int wr, int wc, int fr, int fq) const {
        const int row0 = u.pm * BM + wr * 64 + fr, col0 = u.pn * HALF + wc * 32 + 8 * fq;
#pragma unroll
        for (int ai = 0; ai < 2; ++ai)
#pragma unroll
            for (int m = 0; m < 4; ++m) { const f32x4 g0 = acc[ai][0][m][0], g1 = acc[ai][0][m][1], u0 = acc[ai][1][m][0], u1 = acc[ai][1][m][1];
                u32x4 w; w.x = cvt_pk_bf16(sw(g0[0], u0[0]), sw(g0[1], u0[1])); w.y = cvt_pk_bf16(sw(g0[2], u0[2]), sw(g0[3], u0[3]));
                w.z = cvt_pk_bf16(sw(g1[0], u1[0]), sw(g1[1], u1[1])); w.w = cvt_pk_bf16(sw(g1[2], u1[2]), sw(g1[3], u1[3]));
                *(u32x4*)(ACT + (size_t)(row0 + ai * HALF + m * 16) * 2816 + col0) = w; }
    }
};
template <class Epi, class Sched, bool ALIGN_EPI = false, bool SP2 = false>
__device__ __forceinline__ void gemm_phase(PG8_LAS unsigned char* lds, const Gemm g, const Sched& S, const Epi& E, const int tid) {
    const int wid = __builtin_amdgcn_readfirstlane(tid >> 6), lane = tid & 63, wr = wid >> 2, wc = wid & 3, fr = lane & 15, fq = lane >> 4;
    const int K = g.K, nt = K / BK;
    unsigned voffA[2], voffB[2];
#pragma unroll
    for (int i = 0; i < 2; ++i) { int R, C; stage_rc(tid * 16 + i * 8192, R, C); const int Rb = Epi::PERM ? ((R & ~31) + perm32(R & 31)) : R;
        voffA[i] = (unsigned)(R * K + C) * 2u; voffB[i] = (unsigned)(Rb * K + C) * 2u; }
    const size_t kstep = (size_t)(BK * 2);
    const size_t hstep = (size_t)HALF * K * 2;
    const size_t tstep = 2 * hstep;
    const unsigned ldsw = (unsigned)wid * 1024u;
    const int aoff = lds_byte(wr * 64 + fr, fq * 8), boff = lds_byte(wc * 32 + fr, fq * 8);
#define PG8_SA(b, h) (((b) * 2 + (h)) * HTB)
#define PG8_SB(b, h) ((4 + (b) * 2 + (h)) * HTB)
#define PG8_STAGE(bufoff, gbase, voff) do { _Pragma("unroll") for (int _i = 0; _i < 2; ++_i) \
        __builtin_amdgcn_global_load_lds((const unsigned*)((const char*)(gbase) + (voff)[_i]), (PG8_LAS unsigned*)(lds + (bufoff) + ldsw + _i * 8192), 16, 0, 0); } while (0)
#define PG8_LDA(dst, b, h) do { _Pragma("unroll") for (int m = 0; m < 4; ++m) _Pragma("unroll") for (int k = 0; k < 2; ++k) dst[m][k] = *(const PG8_LAS bf16x8*)(lds + PG8_SA(b, h) + aoff + m * 2048 + k * 1024); } while (0)
#define PG8_LDB(dst, b, h) do { _Pragma("unroll") for (int n = 0; n < 2; ++n) _Pragma("unroll") for (int k = 0; k < 2; ++k) dst[n][k] = *(const PG8_LAS bf16x8*)(lds + PG8_SB(b, h) + boff + n * 2048 + k * 1024); } while (0)
#define PG8_MMA(ai, bj, At, Bt) do { __builtin_amdgcn_s_setprio(1); _Pragma("unroll") for (int m = 0; m < 4; ++m) _Pragma("unroll") for (int n = 0; n < 2; ++n) _Pragma("unroll") for (int k = 0; k < 2; ++k) \
        acc[ai][bj][m][n] = __builtin_amdgcn_mfma_f32_16x16x32_bf16(Bt[n][k], At[m][k], acc[ai][bj][m][n], 0, 0, 0); __builtin_amdgcn_s_setprio(0); } while (0)
#define PG8_WAIT_V(n) asm volatile("s_waitcnt vmcnt(" #n ")" ::: "memory")
#define PG8_WAIT_L(n) asm volatile("s_waitcnt lgkmcnt(" #n ")" ::: "memory")
#define PG8_BAR __builtin_amdgcn_s_barrier()
#define PG8_SCHED __builtin_amdgcn_sched_barrier(0)
    Unit cur, nxt; int ui = 0;
    if (!S.next(0, cur)) return;
    f32x4 acc[2][2][4][2];
#pragma unroll
    for (int a = 0; a < 2; ++a)
#pragma unroll
        for (int b = 0; b < 2; ++b)
#pragma unroll
            for (int m = 0; m < 4; ++m)
#pragma unroll
                for (int n = 0; n < 2; ++n) acc[a][b][m][n] = (f32x4){0.f, 0.f, 0.f, 0.f};
    bf16x8 At[4][2], B0[2][2], B1[2][2];
    const char* cA = (const char*)g.A + (size_t)cur.pm * tstep; const char* cB = (const char*)g.Bt + (size_t)cur.pn * tstep;
    S.a_ready(cur);
    if constexpr (SP2) {
        PG8_STAGE(PG8_SB(0, 0), cB, voffB); PG8_STAGE(PG8_SB(0, 1), cB + hstep, voffB); PG8_STAGE(PG8_SA(0, 0), cA, voffA); PG8_STAGE(PG8_SA(0, 1), cA + hstep, voffA);
        if (wr == 1) PG8_BAR;
        PG8_WAIT_V(2); PG8_BAR;
        PG8_STAGE(PG8_SB(1, 0), cB + kstep, voffB); PG8_STAGE(PG8_SA(1, 0), cA + kstep, voffA); PG8_STAGE(PG8_SB(1, 1), cB + hstep + kstep, voffB);
        PG8_WAIT_V(6); PG8_BAR;
    } else {
        PG8_STAGE(PG8_SB(0, 0), cB, voffB); PG8_STAGE(PG8_SA(0, 0), cA, voffA); PG8_STAGE(PG8_SB(0, 1), cB + hstep, voffB); PG8_STAGE(PG8_SA(0, 1), cA + hstep, voffA);
        if (wr == 1) PG8_BAR;
        PG8_WAIT_V(4); PG8_BAR;
        PG8_STAGE(PG8_SB(1, 0), cB + kstep, voffB); PG8_STAGE(PG8_SA(1, 0), cA + kstep, voffA); PG8_STAGE(PG8_SB(1, 1), cB + hstep + kstep, voffB);
        PG8_WAIT_V(6); PG8_BAR;
    }
    for (;;) {
        const bool has_next = S.next(ui + 1, nxt);
        const char* nA = has_next ? (const char*)g.A + (size_t)nxt.pm * tstep : cA; const char* nB = has_next ? (const char*)g.Bt + (size_t)nxt.pn * tstep : cB;
        for (int t = 0; t < nt; t += 2) {
            const bool last = (t == nt - 2);
            const char* a1 = cA + (size_t)(t + 1) * kstep;
            const char* a2 = last ? nA : cA + (size_t)(t + 2) * kstep; const char* b2 = last ? nB : cB + (size_t)(t + 2) * kstep;
            const char* a3 = a2 + kstep; const char* b3 = b2 + kstep;
            if (last && has_next) S.a_ready(nxt);
            if constexpr (SP2) {
            PG8_LDB(B0, 0, 0); PG8_LDB(B1, 0, 1); PG8_SCHED; PG8_LDA(At, 0, 0); PG8_STAGE(PG8_SA(1, 1), a1 + hstep, voffA);
            PG8_WAIT_V(8); PG8_WAIT_L(0); PG8_BAR; PG8_MMA(0, 0, At, B0); PG8_MMA(0, 1, At, B1); PG8_BAR; PG8_SCHED;
            PG8_LDA(At, 0, 1); PG8_STAGE(PG8_SB(0, 0), b2, voffB); PG8_STAGE(PG8_SB(0, 1), b2 + hstep, voffB); PG8_STAGE(PG8_SA(0, 0), a2, voffA);
            PG8_WAIT_V(8); PG8_WAIT_L(0); PG8_BAR; PG8_MMA(1, 0, At, B0); PG8_MMA(1, 1, At, B1); PG8_BAR; PG8_SCHED;
            PG8_LDB(B0, 1, 0); PG8_LDB(B1, 1, 1); PG8_SCHED; PG8_LDA(At, 1, 0); PG8_STAGE(PG8_SA(0, 1), a2 + hstep, voffA);
            PG8_WAIT_V(8); PG8_WAIT_L(0); PG8_BAR; PG8_MMA(0, 0, At, B0); PG8_MMA(0, 1, At, B1); PG8_BAR; PG8_SCHED;
            PG8_LDA(At, 1, 1); PG8_STAGE(PG8_SB(1, 0), b3, voffB); PG8_STAGE(PG8_SB(1, 1), b3 + hstep, voffB); PG8_STAGE(PG8_SA(1, 0), a3, voffA);
            PG8_WAIT_V(8); PG8_WAIT_L(0); PG8_BAR; PG8_MMA(1, 0, At, B0); PG8_MMA(1, 1, At, B1); PG8_BAR; PG8_SCHED;
            } else {
            PG8_LDB(B0, 0, 0); PG8_SCHED; PG8_LDA(At, 0, 0); PG8_STAGE(PG8_SA(1, 1), a1 + hstep, voffA);
            PG8_WAIT_L(8); PG8_BAR; PG8_WAIT_L(0); PG8_MMA(0, 0, At, B0); PG8_BAR; PG8_SCHED;
            PG8_LDB(B1, 0, 1); PG8_STAGE(PG8_SB(0, 0), b2, voffB);
            PG8_BAR; PG8_WAIT_L(0); PG8_MMA(0, 1, At, B1); PG8_BAR;
            PG8_LDA(At, 0, 1); PG8_STAGE(PG8_SA(0, 0), a2, voffA);
            PG8_BAR; PG8_WAIT_L(0); PG8_MMA(1, 0, At, B0); PG8_BAR; PG8_SCHED;
            PG8_STAGE(PG8_SB(0, 1), b2 + hstep, voffB);
            PG8_WAIT_V(6); PG8_BAR; PG8_MMA(1, 1, At, B1); PG8_BAR;
            PG8_LDB(B0, 1, 0); PG8_SCHED; PG8_LDA(At, 1, 0); PG8_STAGE(PG8_SA(0, 1), a2 + hstep, voffA);
            PG8_WAIT_L(8); PG8_BAR; PG8_WAIT_L(0); PG8_MMA(0, 0, At, B0); PG8_BAR; PG8_SCHED;
            PG8_LDB(B1, 1, 1); PG8_STAGE(PG8_SB(1, 0), b3, voffB);
            PG8_BAR; PG8_WAIT_L(0); PG8_MMA(0, 1, At, B1); PG8_BAR;
            PG8_LDA(At, 1, 1); PG8_STAGE(PG8_SA(1, 0), a3, voffA);
            PG8_BAR; PG8_WAIT_L(0); PG8_MMA(1, 0, At, B0); PG8_BAR; PG8_SCHED;
            PG8_STAGE(PG8_SB(1, 1), b3 + hstep, voffB);
            PG8_WAIT_V(6); PG8_BAR; PG8_MMA(1, 1, At, B1); PG8_BAR;
            }
        }
        if constexpr (ALIGN_EPI) { if (wr == 0) PG8_BAR; }
        if constexpr (!Epi::AFTER_DRAIN) { E(acc, cur, wr, wc, fr, fq); S.done(cur); }
        if (!has_next) break;
#pragma unroll
        for (int a = 0; a < 2; ++a)
#pragma unroll
            for (int b = 0; b < 2; ++b)
#pragma unroll
                for (int m = 0; m < 4; ++m)
#pragma unroll
                    for (int n = 0; n < 2; ++n) acc[a][b][m][n] = (f32x4){0.f, 0.f, 0.f, 0.f};
        cur = nxt; cA = nA; cB = nB; ++ui;
        if constexpr (ALIGN_EPI) { if (wr == 1) PG8_BAR; }
    }
    PG8_WAIT_V(0);
    if constexpr (!ALIGN_EPI) { if (wr == 0) PG8_BAR; }
    PG8_BAR;
    if constexpr (Epi::AFTER_DRAIN) { E.fused(acc, cur, wr, wc, fr, fq, lds, wid, lane); S.done(cur); }
#undef PG8_SA
#undef PG8_SB
#undef PG8_STAGE
#undef PG8_LDA
#undef PG8_LDB
#undef PG8_MMA
#undef PG8_WAIT_V
#undef PG8_WAIT_L
#undef PG8_BAR
#undef PG8_SCHED
}
}
namespace att {
using bf16 = __hip_bfloat16;
constexpr int   D = 128, NW = 8, QBLK = 32, KVBLK = 64;
constexpr float SCALE = 0.088388347648318440f;
constexpr float THR = 8.f;
constexpr int SDEPTH = 2;
constexpr int LDQ = 2048, LDK = 2048, LDO = 1024;
constexpr size_t SHM_V = KVBLK * D * 2, SHM_K = KVBLK * D * 2, SHM_ATTN = 2 * SHM_V + 2 * SHM_K + NW * 64 * 4;
using bf16x8 = __attribute__((ext_vector_type(8))) short;
using s16x4  = __attribute__((ext_vector_type(4))) short;
using f32x16 = __attribute__((ext_vector_type(16))) float;
using f32x8  = __attribute__((ext_vector_type(8))) float;
using u32x4  = __attribute__((ext_vector_type(4))) unsigned;
#define KSWZ(row, colB) ((row) * 256 + ((colB) ^ (((row) & 7) << 4)))
#define SBAR() __builtin_amdgcn_sched_barrier(0)
__device__ __forceinline__ int crow(int r, int hi) { return (r & 3) + 8 * (r >> 2) + 4 * hi; }
__device__ __forceinline__ unsigned cvtpk(float lo, float hi) {
  unsigned r; asm volatile("v_cvt_pk_bf16_f32 %0, %1, %2" : "=v"(r) : "v"(lo), "v"(hi)); return r;
}
template <typename TIn> struct Stage;
template <> struct Stage<bf16>  { using T = bf16x8;
  __device__ static __forceinline__ T ld8(const bf16* p) { return *reinterpret_cast<const bf16x8*>(p); }
  __device__ static __forceinline__ bf16x8 tobf(T x) { return x; } };
template <> struct Stage<float> { using T = f32x8;
  __device__ static __forceinline__ T ld8(const float* p) { return *reinterpret_cast<const f32x8*>(p); }
  __device__ static __forceinline__ bf16x8 tobf(T x) {
    u32x4 w = {cvtpk(x[0], x[1]), cvtpk(x[2], x[3]), cvtpk(x[4], x[5]), cvtpk(x[6], x[7])}; return *reinterpret_cast<bf16x8*>(&w); } };

template <bool FIXED>
__device__ __forceinline__ void partialSM(f32x16& p0, f32x16& p1, float& m_reg, float& mn, float& alpha) {
  if constexpr (FIXED) { mn = 0.f; alpha = 1.f; }
  else {
    float pmax = p0[0]; for (int r = 1; r < 16; ++r) pmax = fmaxf(pmax, p0[r]); for (int r = 0; r < 16; ++r) pmax = fmaxf(pmax, p1[r]);
    { auto rr = __builtin_amdgcn_permlane32_swap(__float_as_uint(pmax), __float_as_uint(pmax), false, false);
      pmax = fmaxf(__uint_as_float(rr[0]), __uint_as_float(rr[1])); }
    if (__builtin_expect(__all(pmax - m_reg <= THR), 1)) { mn = m_reg; alpha = 1.f; }
    else { mn = fmaxf(m_reg, pmax); alpha = __builtin_amdgcn_exp2f(m_reg - mn); m_reg = mn; }
    for (int r = 0; r < 16; ++r) p0[r] -= mn; for (int r = 0; r < 16; ++r) p1[r] -= mn;
  }
  for (int r = 0; r < 16; ++r) p0[r] = __builtin_amdgcn_exp2f(p0[r]);
}
__device__ __forceinline__ void finishSM(f32x16& p0, f32x16& p1, float alpha, float& l_reg, bf16x8& pa0, bf16x8& pa1, bf16x8& pa2, bf16x8& pa3) {
  for (int r = 0; r < 16; ++r) p1[r] = __builtin_amdgcn_exp2f(p1[r]);
  float ps = 0; for (int r = 0; r < 16; ++r) ps += p0[r]; for (int r = 0; r < 16; ++r) ps += p1[r];
  asm volatile("" : "+v"(ps));
  l_reg = l_reg * alpha + ps;
#define PK4(P, BASE, OUT) do { u32x4 w = {cvtpk(P[BASE + 0], P[BASE + 1]), cvtpk(P[BASE + 2], P[BASE + 3]), cvtpk(P[BASE + 4], P[BASE + 5]), cvtpk(P[BASE + 6], P[BASE + 7])}; \
    OUT = *reinterpret_cast<bf16x8*>(&w); } while (0)
  PK4(p0, 0, pa0); PK4(p0, 8, pa1); PK4(p1, 0, pa2); PK4(p1, 8, pa3);
#undef PK4
}
__device__ __forceinline__ void qkt(f32x16& p0, f32x16& p1, const bf16* Ks, const bf16x8* qr, int r32, int hi) {
  p0 = f32x16{}; p1 = f32x16{};
  for (int d0 = 0; d0 < 8; ++d0) { int cb = (d0 * 16 + hi * 8) * 2;
    bf16x8 b0 = *reinterpret_cast<const bf16x8*>((const char*)Ks + KSWZ(r32, cb));
    bf16x8 b1 = *reinterpret_cast<const bf16x8*>((const char*)Ks + KSWZ(32 + r32, cb));
    p0 = __builtin_amdgcn_mfma_f32_32x32x16_bf16(b0, qr[d0], p0, 0, 0, 0);
    p1 = __builtin_amdgcn_mfma_f32_32x32x16_bf16(b1, qr[d0], p1, 0, 0, 0); }
}
__device__ __forceinline__ int v_st(int k, int c) { const int kk = k;
  return ((kk >> 3) * 4 + (c >> 5)) * 512 + ((kk & 7) * 32 + (c & 31)) * 2; }
__device__ __forceinline__ int v_rd_base(int lane) { return ((lane & 3) << 3) | (((lane >> 2) & 3) << 6) | (((lane >> 4) & 1) << 5) | (((lane >> 5) & 1) << 8); }
constexpr int v_rd_off(int d0, int ks, int half) { return d0 * 512 + ks * 4096 + half * 2048; }
template <int OFF> __device__ __forceinline__ s16x4 tr_read(int vb) {
  s16x4 r; asm volatile("ds_read_b64_tr_b16 %0, %1 offset:%2" : "=&v"(r) : "v"(vb), "i"(OFF) : "memory"); return r;
}
template <int D0> __device__ __forceinline__ void pv_one(f32x16& od, int vb, bf16x8 pa0, bf16x8 pa1, bf16x8 pa2, bf16x8 pa3) {
  const s16x4 l0 = tr_read<v_rd_off(D0, 0, 0)>(vb), h0 = tr_read<v_rd_off(D0, 0, 1)>(vb), l1 = tr_read<v_rd_off(D0, 1, 0)>(vb), h1 = tr_read<v_rd_off(D0, 1, 1)>(vb);
  const s16x4 l2 = tr_read<v_rd_off(D0, 2, 0)>(vb), h2 = tr_read<v_rd_off(D0, 2, 1)>(vb), l3 = tr_read<v_rd_off(D0, 3, 0)>(vb), h3 = tr_read<v_rd_off(D0, 3, 1)>(vb);
  asm volatile("s_waitcnt lgkmcnt(0)" ::: "memory"); SBAR();
#define PK(L, H) (bf16x8){L[0], L[1], L[2], L[3], H[0], H[1], H[2], H[3]}
  od = __builtin_amdgcn_mfma_f32_32x32x16_bf16(pa0, PK(l0, h0), od, 0, 0, 0);
  od = __builtin_amdgcn_mfma_f32_32x32x16_bf16(pa1, PK(l1, h1), od, 0, 0, 0);
  od = __builtin_amdgcn_mfma_f32_32x32x16_bf16(pa2, PK(l2, h2), od, 0, 0, 0);
  od = __builtin_amdgcn_mfma_f32_32x32x16_bf16(pa3, PK(l3, h3), od, 0, 0, 0);
#undef PK
}
__device__ __forceinline__ void pv_d0(f32x16* o, int vb, bf16x8 pa0, bf16x8 pa1, bf16x8 pa2, bf16x8 pa3) {
  pv_one<0>(o[0], vb, pa0, pa1, pa2, pa3); pv_one<1>(o[1], vb, pa0, pa1, pa2, pa3); pv_one<2>(o[2], vb, pa0, pa1, pa2, pa3); pv_one<3>(o[3], vb, pa0, pa1, pa2, pa3);
}

__device__ __forceinline__ void load_q_normed(const bf16* Qw, const float* qnw, const float2* rope, int trow, int hi, bf16x8* qr) {
  constexpr float C = SCALE * 1.4426950408889634f;
  float v[8][8]; float ss = 0.f;
#pragma unroll
  for (int d0 = 0; d0 < 8; ++d0) { const u32x4 raw = *reinterpret_cast<const u32x4*>(Qw + d0 * 16);
    v[d0][0] = __uint_as_float(raw.x << 16); v[d0][1] = __uint_as_float(raw.x & 0xffff0000u); v[d0][2] = __uint_as_float(raw.y << 16); v[d0][3] = __uint_as_float(raw.y & 0xffff0000u);
    v[d0][4] = __uint_as_float(raw.z << 16); v[d0][5] = __uint_as_float(raw.z & 0xffff0000u); v[d0][6] = __uint_as_float(raw.w << 16); v[d0][7] = __uint_as_float(raw.w & 0xffff0000u);
#pragma unroll
    for (int j = 0; j < 8; ++j) ss += v[d0][j] * v[d0][j]; }
  { auto rr = __builtin_amdgcn_permlane32_swap(__float_as_uint(ss), __float_as_uint(ss), false, false); ss = __uint_as_float(rr[0]) + __uint_as_float(rr[1]); }
  const float rstd = rsqrtf(ss * (1.0f / 128.0f) + 1e-6f);
#pragma unroll
  for (int d0 = 0; d0 < 8; ++d0) { const float* wp = qnw + d0 * 16 + hi * 8;
#pragma unroll
    for (int j = 0; j < 8; ++j) v[d0][j] = (v[d0][j] * rstd) * (wp[j] * C); }
  if (trow >= 0) {
#pragma unroll
    for (int ax = 0; ax < 2; ++ax) { const float2* rp = rope + (ax ? (trow & 63) : (trow >> 6)) * 32 + hi * 8;
#pragma unroll
      for (int b = 0; b < 2; ++b)
#pragma unroll
        for (int j = 0; j < 8; ++j) { const float2 cs = rp[16 * b + j]; const float x1 = v[4 * ax + b][j], x2 = v[4 * ax + b + 2][j];
          v[4 * ax + b][j] = x1 * cs.x - x2 * cs.y; v[4 * ax + b + 2][j] = x2 * cs.x + x1 * cs.y; } } }
#pragma unroll
  for (int d0 = 0; d0 < 8; ++d0) { u32x4 w = {cvtpk(v[d0][0], v[d0][1]), cvtpk(v[d0][2], v[d0][3]), cvtpk(v[d0][4], v[d0][5]), cvtpk(v[d0][6], v[d0][7])}; qr[d0] = *reinterpret_cast<bf16x8*>(&w); }
}
template <typename TQ, bool FIXED>
__device__ __forceinline__ void attn_dense_body(const TQ* __restrict__ Qb, const bf16* __restrict__ Kh, const bf16* __restrict__ Vh,
                                                bf16* __restrict__ Ob, int seq, char* lds, const int tid, const float* qnw, const float2* rope, const int t0) {
  using St = Stage<bf16>; using SQ = Stage<TQ>;
  const int wid = tid >> 6, lane = tid & 63, r32 = lane & 31, hi = lane >> 5;
  bf16* V_lds = (bf16*)lds; bf16* K_lds = (bf16*)(lds + 2 * SHM_V);
  float* ws = (float*)(lds + 2 * SHM_V + 2 * SHM_K) + wid * 64; float* li_l = ws; float* al_l = ws + 32;
  float m_reg = FIXED ? 0.f : -1e30f, l_reg = 0; f32x16 o[4] = {}; bf16x8 qr[8];
  const TQ* Qw = Qb + (long)(wid * QBLK + r32) * LDQ + hi * 8;
  load_q_normed(Qw, qnw, rope, t0 < 0 ? -1 : t0 + wid * QBLK + r32, hi, qr);
  const int sr = tid >> 4, sc = (tid & 15) * 8, vst0 = v_st(sr, sc), vst1 = v_st(32 + sr, sc);
  const int vb0 = (int)(uintptr_t)V_lds + v_rd_base(lane);
  struct { typename St::T vs0, vs1, ks0, ks1; } sr_[SDEPTH];
#define SLOAD(i, k0) do { sr_[i].vs0 = St::ld8(&Vh[(long)((k0) + sr) * LDK + sc]); sr_[i].vs1 = St::ld8(&Vh[(long)((k0) + 32 + sr) * LDK + sc]); \
    sr_[i].ks0 = St::ld8(&Kh[(long)((k0) + sr) * LDK + sc]); sr_[i].ks1 = St::ld8(&Kh[(long)((k0) + 32 + sr) * LDK + sc]); } while (0)
#define SWRITE(b, i) do { *(bf16x8*)((char*)V_lds + (b) * SHM_V + vst0) = St::tobf(sr_[i].vs0);          \
    *(bf16x8*)((char*)V_lds + (b) * SHM_V + vst1) = St::tobf(sr_[i].vs1); int kc = sc * 2;               \
    *(bf16x8*)((char*)K_lds + (b) * SHM_K + KSWZ(sr, kc)) = St::tobf(sr_[i].ks0);                       \
    *(bf16x8*)((char*)K_lds + (b) * SHM_K + KSWZ(32 + sr, kc)) = St::tobf(sr_[i].ks1); } while (0)
#define SWAIT() do { if constexpr (SDEPTH == 2) asm volatile("s_waitcnt vmcnt(4)" ::: "memory"); else asm volatile("s_waitcnt vmcnt(0)" ::: "memory"); } while (0)
#define RESC(a) do { if (__any((a) < 1.f)) { if (hi == 0) al_l[r32] = (a); asm volatile("s_waitcnt lgkmcnt(0)" ::: "memory"); \
    for (int d = 0; d < 4; ++d) for (int r = 0; r < 16; ++r) o[d][r] *= al_l[crow(r, hi)]; } } while (0)
  f32x16 pA0, pA1, pB0, pB1; float mnA, mnB, alA, alB; bf16x8 pa0, pa1, pa2, pa3; const int NT = seq / KVBLK;
  constexpr int SE = 0, SO = SDEPTH - 1;
  SLOAD(SE, 0); asm volatile("s_waitcnt vmcnt(0)" ::: "memory"); SWRITE(0, SE); __syncthreads();
  qkt(pA0, pA1, K_lds, qr, r32, hi); partialSM<FIXED>(pA0, pA1, m_reg, mnA, alA);
  SLOAD(SO, KVBLK); if constexpr (SDEPTH == 2) { if (2 < NT) SLOAD(SE, 2 * KVBLK); }
  SWAIT(); SWRITE(1, SO); __syncthreads();
  for (int j = 1; j + 1 < NT; j += 2) {
    SBAR(); qkt(pB0, pB1, (bf16*)((char*)K_lds + SHM_K), qr, r32, hi);
    finishSM(pA0, pA1, alA, l_reg, pa0, pa1, pa2, pa3); SBAR();
    SLOAD(SO, (j + SDEPTH) * KVBLK); SBAR();
    pv_d0(o, vb0, pa0, pa1, pa2, pa3); partialSM<FIXED>(pB0, pB1, m_reg, mnB, alB);
    __syncthreads(); SWAIT(); SWRITE(0, SE);
    RESC(alB); __syncthreads();
    SBAR(); qkt(pA0, pA1, K_lds, qr, r32, hi);
    finishSM(pB0, pB1, alB, l_reg, pa0, pa1, pa2, pa3); SBAR();
    if (SDEPTH == 1 || j + 3 < NT) SLOAD(SE, (j + 1 + SDEPTH) * KVBLK); SBAR();
    pv_d0(o, vb0 + (int)SHM_V, pa0, pa1, pa2, pa3); partialSM<FIXED>(pA0, pA1, m_reg, mnA, alA);
    __syncthreads(); SWAIT(); SWRITE(1, SO);
    RESC(alA); __syncthreads();
  }
  SBAR(); qkt(pB0, pB1, (bf16*)((char*)K_lds + SHM_K), qr, r32, hi);
  finishSM(pA0, pA1, alA, l_reg, pa0, pa1, pa2, pa3); SBAR();
  pv_d0(o, vb0, pa0, pa1, pa2, pa3); partialSM<FIXED>(pB0, pB1, m_reg, mnB, alB);
  __syncthreads(); RESC(alB);
  finishSM(pB0, pB1, alB, l_reg, pa0, pa1, pa2, pa3); SBAR();
  pv_d0(o, vb0 + (int)SHM_V, pa0, pa1, pa2, pa3);
  { auto rr = __builtin_amdgcn_permlane32_swap(__float_as_uint(l_reg), __float_as_uint(l_reg), false, false); l_reg = __uint_as_float(rr[0]) + __uint_as_float(rr[1]); }
  if (hi == 0) li_l[r32] = l_reg; asm volatile("s_waitcnt lgkmcnt(0)" ::: "memory");
  float rli[16];
#pragma unroll
  for (int r = 0; r < 16; ++r) rli[r] = __builtin_amdgcn_rcpf(li_l[crow(r, hi)]);
  bf16* Ow = Ob + (long)(wid * QBLK) * LDO;
#pragma unroll
  for (int r = 0; r < 16; ++r) { int orow = crow(r, hi);
    for (int d0 = 0; d0 < 4; ++d0) Ow[(long)orow * LDO + d0 * 32 + r32] = __float2bfloat16(o[d0][r] * rli[r]); }
#undef SLOAD
#undef SWRITE
#undef SWAIT
#undef RESC
}

constexpr size_t SHM_ATTN_DMA = 4 * SHM_V + 4 * SHM_K + NW * 64 * 4;
#define ATT_LAS __attribute__((address_space(3)))
template <typename TQ>
__device__ __forceinline__ void attn_dense_body_dma(const TQ* __restrict__ Qb, const bf16* __restrict__ Kh, const bf16* __restrict__ Vh,
                                                    bf16* __restrict__ Ob, int seq, char* lds, const int tid, const float* qnw, const float2* rope, const int t0) {
  using SQ = Stage<TQ>;
  const int wid = __builtin_amdgcn_readfirstlane(tid >> 6), lane = tid & 63, r32 = lane & 31, hi = lane >> 5;
  char* V_lds = lds; char* K_lds = lds + 4 * SHM_V;
  float* ws = (float*)(lds + 4 * SHM_V + 4 * SHM_K) + wid * 64; float* li_l = ws;
  float m_reg = 0.f, l_reg = 0; f32x16 o[4] = {}; bf16x8 qr[8];
  const TQ* Qw = Qb + (long)(wid * QBLK + r32) * LDQ + hi * 8;
  load_q_normed(Qw, qnw, rope, t0 < 0 ? -1 : t0 + wid * QBLK + r32, hi, qr);
  const int vb0 = (int)(uintptr_t)V_lds + v_rd_base(lane);
  int koff[2], voff[2];
#pragma unroll
  for (int i = 0; i < 2; ++i) { const int P = wid * 1024 + lane * 16 + i * 8192;
    { const int row = P >> 8, colB = (P & 255) ^ ((row & 7) << 4); koff[i] = row * LDK + (colB >> 1); }
    { const int sub = P >> 9, k = (sub >> 2) * 8 + ((lane & 31) >> 2), c = (sub & 3) * 32 + (lane & 3) * 8; voff[i] = k * LDK + c; } }
#define DMA_TILE(t, slot) do { const bf16* kb_ = Kh + (long)(t) * (KVBLK * LDK); const bf16* vb_ = Vh + (long)(t) * (KVBLK * LDK); \
    __builtin_amdgcn_global_load_lds((const unsigned*)(kb_ + koff[0]), (ATT_LAS unsigned*)(K_lds + (slot) * SHM_K + wid * 1024), 16, 0, 0); \
    __builtin_amdgcn_global_load_lds((const unsigned*)(kb_ + koff[1]), (ATT_LAS unsigned*)(K_lds + (slot) * SHM_K + 8192 + wid * 1024), 16, 0, 0); \
    __builtin_amdgcn_global_load_lds((const unsigned*)(vb_ + voff[0]), (ATT_LAS unsigned*)(V_lds + (slot) * SHM_V + wid * 1024), 16, 0, 0); \
    __builtin_amdgcn_global_load_lds((const unsigned*)(vb_ + voff[1]), (ATT_LAS unsigned*)(V_lds + (slot) * SHM_V + 8192 + wid * 1024), 16, 0, 0); } while (0)
#define PUBLISH(n) do { asm volatile("s_waitcnt vmcnt(" #n ")" ::: "memory"); asm volatile("s_waitcnt lgkmcnt(0)" ::: "memory"); __builtin_amdgcn_s_barrier(); SBAR(); } while (0)
  f32x16 pA0, pA1, pB0, pB1; float mnA, mnB, alA, alB; bf16x8 pa0, pa1, pa2, pa3; const int NT = seq / KVBLK;
  DMA_TILE(0, 0); DMA_TILE(1, 1);
  PUBLISH(4);
  qkt(pA0, pA1, (const bf16*)K_lds, qr, r32, hi); partialSM<true>(pA0, pA1, m_reg, mnA, alA);
  DMA_TILE(2, 2);
  PUBLISH(4);
  for (int j = 1; j + 1 < NT; j += 2) {
    SBAR(); qkt(pB0, pB1, (const bf16*)(K_lds + (j & 3) * (int)SHM_K), qr, r32, hi);
    finishSM(pA0, pA1, alA, l_reg, pa0, pa1, pa2, pa3); SBAR();
    DMA_TILE(j + 2, (j + 2) & 3); SBAR();
    pv_d0(o, vb0 + ((j - 1) & 3) * (int)SHM_V, pa0, pa1, pa2, pa3); partialSM<true>(pB0, pB1, m_reg, mnB, alB);
    PUBLISH(4);
    SBAR(); qkt(pA0, pA1, (const bf16*)(K_lds + ((j + 1) & 3) * (int)SHM_K), qr, r32, hi);
    finishSM(pB0, pB1, alB, l_reg, pa0, pa1, pa2, pa3); SBAR();
    if (j + 3 < NT) { DMA_TILE(j + 3, (j + 3) & 3); } SBAR();
    pv_d0(o, vb0 + (j & 3) * (int)SHM_V, pa0, pa1, pa2, pa3); partialSM<true>(pA0, pA1, m_reg, mnA, alA);
    if (j + 3 < NT) { PUBLISH(4); } else { PUBLISH(0); }
  }
  SBAR(); qkt(pB0, pB1, (const bf16*)(K_lds + ((NT - 1) & 3) * (int)SHM_K), qr, r32, hi);
  finishSM(pA0, pA1, alA, l_reg, pa0, pa1, pa2, pa3); SBAR();
  pv_d0(o, vb0 + ((NT - 2) & 3) * (int)SHM_V, pa0, pa1, pa2, pa3); partialSM<true>(pB0, pB1, m_reg, mnB, alB);
  finishSM(pB0, pB1, alB, l_reg, pa0, pa1, pa2, pa3); SBAR();
  pv_d0(o, vb0 + ((NT - 1) & 3) * (int)SHM_V, pa0, pa1, pa2, pa3);
  { auto rr = __builtin_amdgcn_permlane32_swap(__float_as_uint(l_reg), __float_as_uint(l_reg), false, false); l_reg = __uint_as_float(rr[0]) + __uint_as_float(rr[1]); }
  if (hi == 0) li_l[r32] = l_reg; asm volatile("s_waitcnt lgkmcnt(0)" ::: "memory");
  float rli[16];
#pragma unroll
  for (int r = 0; r < 16; ++r) rli[r] = __builtin_amdgcn_rcpf(li_l[crow(r, hi)]);
  bf16* Ow = Ob + (long)(wid * QBLK) * LDO;
#pragma unroll
  for (int r = 0; r < 16; ++r) { int orow = crow(r, hi);
    for (int d0 = 0; d0 < 4; ++d0) Ow[(long)orow * LDO + d0 * 32 + r32] = __float2bfloat16(o[d0][r] * rli[r]); }
  asm volatile("s_waitcnt vmcnt(0)" ::: "memory");
#undef DMA_TILE
#undef PUBLISH
}
}
constexpr int DM = 1024, LSEQ = 16384, CTXL = 256, NBATCH = 2, SEQU = LSEQ + CTXL, MROWS = NBATCH * SEQU;
constexpr int NU = 2048;
constexpr int NIN = 2304;
constexpr int DFF = 2816, NMODV = 6144;
constexpr int NCHUNK = MROWS / 128, CPB = SEQU / 128;
constexpr float EPSN = 1e-6f;
constexpr size_t MiB = 1u << 20;
constexpr size_t WS_WIN = 0, WS_WOUT = 9 * MiB, WS_W13 = 13 * MiB, WS_W2 = 35 * MiB, WS_MODP = 46 * MiB, WS_MOD = 48 * MiB, WS_ROPE = 49 * MiB, WS_DT = 50 * MiB, WS_CD = 52 * MiB;
constexpr size_t WS_BAR = 52 * MiB + 512 * 1024;
constexpr size_t WS_ST = 53 * MiB, WS_SP = 86 * MiB, WS_XBC = 103 * MiB, WS_HN = 53 * MiB  ;
constexpr size_t WS_XSL = 136 * MiB, WS_XSC = 264 * MiB, WS_U = 266 * MiB, WS_MIX = 396 * MiB, WS_ACT = 266 * MiB  , WS_END = 461 * MiB;
constexpr int LDS_TAB = 149504, LDS_BYTES = 149504 + 512;
constexpr int NPHASE = 20;

typedef unsigned short bf16u;
typedef short bf16x8 __attribute__((ext_vector_type(8)));
typedef short s16x4 __attribute__((ext_vector_type(4)));
typedef float f32x4 __attribute__((ext_vector_type(4)));
typedef unsigned u32x4 __attribute__((ext_vector_type(4)));
typedef unsigned u32x2 __attribute__((ext_vector_type(2)));
#define LDSW() asm volatile("s_waitcnt lgkmcnt(0)" ::: "memory")
__device__ __forceinline__ float bf2f(unsigned short h) { return __uint_as_float((unsigned)h << 16); }
__device__ __forceinline__ float bflo(unsigned w) { return __uint_as_float(w << 16); }
__device__ __forceinline__ float bfhi(unsigned w) { return __uint_as_float(w & 0xffff0000u); }
__device__ __forceinline__ unsigned pk2(float lo, float hi) { return pg8::cvt_pk_bf16(lo, hi); }
__device__ __forceinline__ unsigned short f2bf1(float f) { return (unsigned short)(pg8::cvt_pk_bf16(f, 0.f) & 0xffffu); }
__device__ __forceinline__ float bperm(float v, int srclane) { return __builtin_bit_cast(float, __builtin_amdgcn_ds_bpermute(srclane << 2, __builtin_bit_cast(int, v))); }
__device__ __forceinline__ float rdlane(float v, int l) { return __builtin_bit_cast(float, __builtin_amdgcn_readlane(__builtin_bit_cast(int, v), l)); }
__device__ __forceinline__ float wave_sum(float v, int lane) {
#pragma unroll
    for (int o = 1; o < 64; o <<= 1) v += bperm(v, lane ^ o);
    return v;
}
__device__ __forceinline__ float siluf(float x) { return x * __builtin_amdgcn_rcpf(1.0f + __builtin_amdgcn_exp2f(-1.4426950408889634f * x)); }
__device__ __forceinline__ float softplusf(float x) { return fmaxf(x, 0.f) + log1pf(__expf(-fabsf(x))); }

struct Params {
    const float *x, *c, *ctx, *c_ctx, *norm1_w, *norm2_w, *w_mod, *b_mod, *w_in, *pool_w, *pool_scale, *conv_w, *conv_b, *dt_bias, *a_log, *d_skip, *ssd_norm_w,
                *q_norm_w, *k_norm_w, *w_out, *w1, *w3, *w2;
    float* out; unsigned char* ws; int ph_lo, ph_hi;
};

__device__ __forceinline__ void transpose_tile(const float* W, int ldw, int scol0, bf16u* WT, int K, int n0, int k0, float* scr, int lane) {
    const int nn = lane & 31; const int sc = scol0 >= 0 ? scol0 + nn : ((scol0 == -2 && nn < 8) ? 1024 + nn : -1);
#pragma unroll 8
    for (int i = 0; i < 32; ++i) { const int kk = 2 * i + (lane >> 5); scr[kk * 33 + nn] = sc >= 0 ? W[(size_t)(k0 + kk) * ldw + sc] : 0.f; }
    LDSW();
    const int c = lane & 7;
#pragma unroll
    for (int j = 0; j < 4; ++j) { const int n = (lane >> 3) + 8 * j; const float* s = scr + (8 * c) * 33 + n;
        u32x4 o; o.x = pk2(s[0 * 33], s[1 * 33]); o.y = pk2(s[2 * 33], s[3 * 33]); o.z = pk2(s[4 * 33], s[5 * 33]); o.w = pk2(s[6 * 33], s[7 * 33]);
        *(u32x4*)(WT + (size_t)(n0 + n) * K + k0 + 8 * c) = o; }
    LDSW();
}
constexpr int PREP_I_IN = 16 * 72, PREP_I_OUT = 16 * 32, PREP_I_13 = 16 * 176, PREP_I_2 = 44 * 32, PREP_I_L = PREP_I_IN + PREP_I_OUT + PREP_I_13 + PREP_I_2;
__device__ __forceinline__ void prep_weight_item(const Params& P, int l, int r, float* scr, int lane) {
    if (r < PREP_I_IN) { const int kb = r / 72, nb = r % 72, n0 = 32 * nb; const int sc0 = n0 < 1024 ? n0 : (n0 < 2048 ? n0 + 8 : (n0 == 2048 ? -2 : -1));
        transpose_tile(P.w_in + (size_t)l * 1024 * 2056, 2056, sc0, (bf16u*)(P.ws + WS_WIN) + (size_t)l * NIN * 1024, 1024, n0, 64 * kb, scr, lane); return; }
    r -= PREP_I_IN;
    if (r < PREP_I_OUT) { const int kb = r / 32, nb = r % 32;
        transpose_tile(P.w_out + (size_t)l * 1024 * 1024, 1024, 32 * nb, (bf16u*)(P.ws + WS_WOUT) + (size_t)l * 1024 * 1024, 1024, 32 * nb, 64 * kb, scr, lane); return; }
    r -= PREP_I_OUT;
    if (r < PREP_I_13) { const int kb = r / 176, nb = r % 176, n0 = 32 * nb, pn = n0 >> 8, s = (n0 >> 7) & 1, i0 = n0 & 127;
        transpose_tile((s ? P.w3 : P.w1) + (size_t)l * 1024 * DFF, DFF, 128 * pn + i0, (bf16u*)(P.ws + WS_W13) + (size_t)l * 2 * DFF * 1024, 1024, n0, 64 * kb, scr, lane); return; }
    r -= PREP_I_13;
    { const int kb = r / 32, nb = r % 32;
        transpose_tile(P.w2 + (size_t)l * DFF * 1024, 1024, 32 * nb, (bf16u*)(P.ws + WS_W2) + (size_t)l * 1024 * DFF, DFF, 32 * nb, 64 * kb, scr, lane); }
}
__device__ __forceinline__ void prep_layer1_weights(const Params& P, unsigned char* lds, int lane, int wave, int vb, int nvb) {
    float* scr = (float*)(lds + wave * 8448);
    for (int r = vb * 8 + wave; r < PREP_I_L; r += nvb * 8) prep_weight_item(P, 1, r, scr, lane);
}
__device__ __forceinline__ void phase_prep(const Params& P, unsigned char* lds, int tid, int lane, int wave, int G, const int bid) {
    float* SC = (float*)(lds + 8 * 8448);
    for (int i = tid; i < 3072; i += 512) { const int wh = i >> 10, k = i & 1023; const float v = wh < 2 ? P.c[wh * 1024 + k] : P.c_ctx[k]; SC[i] = siluf(v); }
    __syncthreads();
    float* scr = (float*)(lds + wave * 8448);
    const int gw = bid * 8 + wave, NGW = G * 8;
    constexpr int I_IN = 16 * 72, I_OUT = 16 * 32, I_13 = 16 * 176, I_2 = 44 * 32, I_L = I_IN + I_OUT + I_13 + I_2, I_MOD = 384;
    for (int it = gw; it < I_MOD + I_L; it += NGW) {
        if (it < I_MOD) {
            const int l = it / 192, r = it % 192, cb = r >> 3, ks = r & 7;
            const float* W = P.w_mod + (size_t)l * 1024 * NMODV + (size_t)(ks * 128) * NMODV + cb * 256 + 4 * lane;
            f32x4 a0 = {0.f, 0.f, 0.f, 0.f}, a1 = a0, a2 = a0;
#pragma unroll 8
            for (int k = 0; k < 128; ++k) { const f32x4 w = *(const f32x4*)(W + (size_t)k * NMODV); const int kk = ks * 128 + k;
                a0 += SC[kk] * w; a1 += SC[1024 + kk] * w; a2 += SC[2048 + kk] * w; }
            float* MP = (float*)(P.ws + WS_MODP) + (size_t)((l * 8 + ks) * 3) * NMODV + cb * 256 + 4 * lane;
            *(f32x4*)MP = a0; *(f32x4*)(MP + NMODV) = a1; *(f32x4*)(MP + 2 * NMODV) = a2;
            continue;
        }
        prep_weight_item(P, 0, it - I_MOD, scr, lane);
    }
    for (int i = bid * 512 + tid; i < 256 * 32; i += G * 512) { const int pos = i >> 5, fi = i & 31;
        const float inv = powf(10000.0f, -(float)(2 * fi) / 64.0f); const float ang = (float)pos * inv;
        ((float2*)(P.ws + WS_ROPE))[i] = make_float2(cosf(ang), sinf(ang)); }
}
__device__ __forceinline__ void phase_modreduce(const Params& P, int tid, int G, const int bid) {
    const float* MP = (const float*)(P.ws + WS_MODP); float* MOD = (float*)(P.ws + WS_MOD);
    for (int i = bid * 512 + tid; i < 2 * 3 * NMODV; i += G * 512) { const int l = i / (3 * NMODV), r = i % (3 * NMODV), wh = r / NMODV, col = r % NMODV;
        float v = P.b_mod[l * NMODV + col];
#pragma unroll
        for (int ks = 0; ks < 8; ++ks) v += MP[(size_t)((l * 8 + ks) * 3 + wh) * NMODV + col];
        MOD[i] = v; }
}

template <class T>
__device__ __forceinline__ void phase_norm(const T* xl, const T* xc, const float* nw, const float* mod  , int sh_off, int sc_off,
                                           bf16u* HN, int skip_ctx, int lane, int wave, int G, const int bid) {
    const int gw = bid * 8 + wave, NGW = G * 8; int cur = -1; f32x4 a[4], s[4];
    for (int m = gw; m < MROWS; m += NGW) {
        const int b = m / SEQU, j = m % SEQU; const bool isc = j < CTXL; if (isc && skip_ctx) continue;
        const int wh = isc ? 2 : b; const T* src = isc ? xc + (size_t)(b * CTXL + j) * DM : xl + (size_t)(b * LSEQ + j - CTXL) * DM;
        if (wh != cur) { cur = wh;
#pragma unroll
            for (int jj = 0; jj < 4; ++jj) { const int k = 8 * lane + 4 * (jj & 1) + 512 * (jj >> 1); const f32x4 w = *(const f32x4*)(nw + k), sc = *(const f32x4*)(mod + wh * NMODV + sc_off + k);
                a[jj] = w * (sc + 1.0f); s[jj] = *(const f32x4*)(mod + wh * NMODV + sh_off + k); } }
        f32x4 v[4]; float ss = 0.f;
#pragma unroll
        for (int h = 0; h < 2; ++h) pg8::ld8(src + 8 * lane + 512 * h, v[2 * h], v[2 * h + 1]);
#pragma unroll
        for (int jj = 0; jj < 4; ++jj) ss += (v[jj].x * v[jj].x + v[jj].y * v[jj].y) + (v[jj].z * v[jj].z + v[jj].w * v[jj].w);
        const float rstd = rsqrtf(wave_sum(ss, lane) * (1.0f / DM) + EPSN);
#pragma unroll
        for (int h = 0; h < 2; ++h) pg8::st8(HN + (size_t)m * DM + 8 * lane + 512 * h, (v[2 * h] * rstd) * a[2 * h] + s[2 * h], (v[2 * h + 1] * rstd) * a[2 * h + 1] + s[2 * h + 1]);
    }
}

__device__ __forceinline__ float ssd_dt_arrays(const Params& P, int l, int row0, float* ARR_dt, float* ARR_acs, int lane, int wave) {
    const float* DT = (const float*)(P.ws + WS_DT);
    const float bias = P.dt_bias[l * 8 + wave], A = -__expf(P.a_log[l * 8 + wave]);
    const float d0 = softplusf(DT[(size_t)(row0 + lane) * 8 + wave] + bias), d1 = softplusf(DT[(size_t)(row0 + 64 + lane) * 8 + wave] + bias);
    float p0 = d0 * A, p1 = d1 * A, tot;
    if (wave < 4) {
#pragma unroll
        for (int o = 1; o < 64; o <<= 1) { const float t0 = bperm(p0, lane - o), t1 = bperm(p1, lane - o); if (lane >= o) { p0 += t0; p1 += t1; } }
        const float tot0 = rdlane(p0, 63); p1 += tot0; tot = rdlane(p1, 63);
    } else {
#pragma unroll
        for (int o = 1; o < 64; o <<= 1) { const float t0 = bperm(p0, lane + o), t1 = bperm(p1, lane + o); if (lane + o < 64) { p0 += t0; p1 += t1; } }
        const float tot1 = rdlane(p1, 0); p0 += tot1; tot = rdlane(p0, 0);
    }
    ARR_dt[wave * 128 + lane] = d0; ARR_dt[wave * 128 + 64 + lane] = d1; ARR_acs[wave * 128 + lane] = p0; ARR_acs[wave * 128 + 64 + lane] = p1;
    return tot;
}
constexpr int XT_LD = 136;
__device__ __forceinline__ int xt_row(int ch) { return ch * XT_LD + (ch >> 3) * 8; }
constexpr int XT_BYTES = (256 * XT_LD + 32 * 8) * 2, BT_BYTES = (128 * XT_LD + 16 * 8) * 2;

#ifndef MIX_CHUNK_REP
#define MIX_CHUNK_REP 1
#endif
#ifndef MIX_POOL_REP
#define MIX_POOL_REP 1
#endif
__device__ __forceinline__ void phase_mixprep(const Params& P, int l, unsigned char* lds, int tid, int lane, int wave, int G, const int bid, const bool do_qk) {
    bf16u* U = (bf16u*)(P.ws + WS_U); bf16u* XBC = (bf16u*)(P.ws + WS_XBC); bf16u* MIX = (bf16u*)(P.ws + WS_MIX);
    const int fr = lane & 15, fq = lane >> 4;
    {
        bf16u* XT = (bf16u*)lds; bf16u* BT = (bf16u*)(lds + XT_BYTES); float* ARR_dt = (float*)(lds + XT_BYTES + BT_BYTES); float* ARR_acs = (float*)(lds + XT_BYTES + BT_BYTES + 4096);
        const int cbk = tid & 63, tq = tid >> 6;
        float cw[5][8], cbv[8];
#pragma unroll
        for (int j = 0; j < 5; ++j)
#pragma unroll
            for (int c = 0; c < 8; ++c) cw[j][c] = P.conv_w[(size_t)(l * 5 + j) * 512 + 8 * cbk + c];
#pragma unroll
        for (int c = 0; c < 8; ++c) cbv[c] = P.conv_b[l * 512 + 8 * cbk + c];
        for (int _cr = 0; _cr < MIX_CHUNK_REP; ++_cr)
        for (int ci = bid; ci < NCHUNK; ci += G) {
            const int b = ci / CPB, cb = ci % CPB, row0 = ci * 128;
            const int seq_lo = b * SEQU + (cb < 2 ? 0 : CTXL), seq_hi = b * SEQU + (cb < 2 ? CTXL : SEQU);
            const float tot = ssd_dt_arrays(P, l, row0, ARR_dt, ARR_acs, lane, wave);
            if (lane == 0) ((float*)(P.ws + WS_CD))[ci * 8 + wave] = __expf(tot);
            float win[5][8], olo[8]; unsigned tp[8][4];
#pragma unroll
            for (int j = 0; j < 4; ++j) { const int rr = row0 + 16 * tq + j - 2; u32x4 raw = {0u, 0u, 0u, 0u};
                if (rr >= seq_lo && rr < seq_hi) raw = *(const u32x4*)(U + (size_t)rr * NU + 512 + 8 * cbk);
                win[j][0] = bflo(raw.x); win[j][1] = bfhi(raw.x); win[j][2] = bflo(raw.y); win[j][3] = bfhi(raw.y); win[j][4] = bflo(raw.z); win[j][5] = bfhi(raw.z); win[j][6] = bflo(raw.w); win[j][7] = bfhi(raw.w); }
#pragma unroll
            for (int p = 0; p < 16; ++p) {
                const int tau = 16 * tq + p, rr = row0 + tau + 2; u32x4 raw = {0u, 0u, 0u, 0u};
                if (rr >= seq_lo && rr < seq_hi) raw = *(const u32x4*)(U + (size_t)rr * NU + 512 + 8 * cbk);
                { const int sl = (p + 4) % 5; win[sl][0] = bflo(raw.x); win[sl][1] = bfhi(raw.x); win[sl][2] = bflo(raw.y); win[sl][3] = bfhi(raw.y); win[sl][4] = bflo(raw.z); win[sl][5] = bfhi(raw.z); win[sl][6] = bflo(raw.w); win[sl][7] = bfhi(raw.w); }
                float o[8];
#pragma unroll
                for (int c = 0; c < 8; ++c) { float acc = cbv[c];
#pragma unroll
                    for (int j = 0; j < 5; ++j) acc += cw[j][c] * win[(p + j) % 5][c];
                    o[c] = siluf(acc); }
                u32x4 w; w.x = pk2(o[0], o[1]); w.y = pk2(o[2], o[3]); w.z = pk2(o[4], o[5]); w.w = pk2(o[6], o[7]);
                *(u32x4*)(XBC + (size_t)(row0 + tau) * 512 + 8 * cbk) = w;
                if ((p & 1) == 0) {
#pragma unroll
                    for (int c = 0; c < 8; ++c) olo[c] = o[c];
                } else {
#pragma unroll
                    for (int c = 0; c < 8; ++c) tp[c][(p & 7) >> 1] = pk2(olo[c], o[c]);
                }
                if ((p & 7) == 7 && cbk < 48) {
                    bf16u* T = (cbk < 32 ? XT + xt_row(8 * cbk) : BT + xt_row(8 * (cbk - 32))) + 16 * tq + (p - 7);
#pragma unroll
                    for (int c = 0; c < 8; ++c) { u32x4 tw = {tp[c][0], tp[c][1], tp[c][2], tp[c][3]}; *(u32x4*)(T + c * XT_LD) = tw; }
                }
            }
            __syncthreads();
            {
                const int h = wave & 3, g = h >> 1;
                f32x4 acc[4][4];
#pragma unroll
                for (int m = 0; m < 4; ++m)
#pragma unroll
                    for (int n = 0; n < 4; ++n) acc[m][n] = (f32x4){0.f, 0.f, 0.f, 0.f};
#pragma unroll
                for (int ks = 0; ks < 4; ++ks) {
                    const int tb = 32 * ks + 8 * fq; float wg[8];
#pragma unroll
                    for (int j = 0; j < 8; ++j) wg[j] = __expf(tot - ARR_acs[wave * 128 + tb + j]) * ARR_dt[wave * 128 + tb + j];
                    bf16x8 Af[4], Bf[4];
#pragma unroll
                    for (int m = 0; m < 4; ++m) { const u32x4 raw = *(const u32x4*)(XT + xt_row(h * 64 + 16 * m + fr) + tb);
                        u32x4 sc; sc.x = pk2(bflo(raw.x) * wg[0], bfhi(raw.x) * wg[1]); sc.y = pk2(bflo(raw.y) * wg[2], bfhi(raw.y) * wg[3]);
                        sc.z = pk2(bflo(raw.z) * wg[4], bfhi(raw.z) * wg[5]); sc.w = pk2(bflo(raw.w) * wg[6], bfhi(raw.w) * wg[7]);
                        Af[m] = __builtin_bit_cast(bf16x8, sc); }
#pragma unroll
                    for (int n = 0; n < 4; ++n) Bf[n] = *(const bf16x8*)(BT + xt_row(g * 64 + 16 * n + fr) + tb);
#pragma unroll
                    for (int m = 0; m < 4; ++m)
#pragma unroll
                        for (int n = 0; n < 4; ++n) acc[m][n] = __builtin_amdgcn_mfma_f32_16x16x32_bf16(Bf[n], Af[m], acc[m][n], 0, 0, 0);
                }
                float* ST = (float*)(P.ws + WS_ST) + (size_t)(ci * 8 + wave) * 4096;
#pragma unroll
                for (int m = 0; m < 4; ++m)
#pragma unroll
                    for (int n = 0; n < 4; ++n) *(f32x4*)(ST + (16 * m + fr) * 64 + 16 * n + 4 * fq) = acc[m][n];
            }
            __syncthreads();
        }
    }
    {
        bf16u* UT = (bf16u*)lds; bf16u* PL = (bf16u*)(lds + 40960); constexpr int PL_LD = 264;
        const int g = wave & 3, th = wave >> 2;
        bf16x8 Wf[4][2];
#pragma unroll
        for (int nt = 0; nt < 4; ++nt)
#pragma unroll
            for (int ks = 0; ks < 2; ++ks) { const float* wp = P.pool_w + (size_t)((l * 4 + g) * 64 + 32 * ks + 8 * fq) * 64 + 16 * nt + fr;
                u32x4 w; w.x = pk2(wp[0], wp[64]); w.y = pk2(wp[128], wp[192]); w.z = pk2(wp[256], wp[320]); w.w = pk2(wp[384], wp[448]); Wf[nt][ks] = __builtin_bit_cast(bf16x8, w); }
        f32x4 pscv[4];
#pragma unroll
        for (int nt = 0; nt < 4; ++nt) pscv[nt] = *(const f32x4*)(P.pool_scale + l * 256 + g * 64 + 16 * nt + 4 * fq);
        const int nx = (NCHUNK > G && NCHUNK - G < G / 2) ? NCHUNK - G : 0, vb = bid - nx, GV = G - nx;
        for (int _pr = 0; _pr < MIX_POOL_REP; ++_pr)
        if (bid >= nx)
        for (int pi = vb; pi < 2 * NCHUNK; pi += GV) {
            const int row0 = pi * 64, b = row0 / SEQU, j0 = row0 % SEQU; const bool isc = j0 < CTXL; if (isc && l == 1) continue;
            const int seq_lo = b * SEQU + (isc ? 0 : CTXL), seq_hi = b * SEQU + (isc ? CTXL : SEQU);
            for (int q = tid; q < 80 * 32; q += 512) { const int rl = q >> 5, cp = q & 31, rr = row0 - 8 + rl;
                u32x4 v = {0u, 0u, 0u, 0u}; if (rr >= seq_lo && rr < seq_hi) v = *(const u32x4*)(U + (size_t)rr * NU + 8 * cp);
                *(u32x4*)(UT + rl * 256 + 8 * cp) = v; }
            __syncthreads();
            { const int ch = tid & 255, hf = tid >> 8, gg = ch >> 6, w = 2 << gg, hw = w >> 1;
              const bf16u* col = UT + ch;
              const int t0 = hf * 32; float sum = 0.f;
              for (int k = -hw; k < hw; ++k) sum += bf2f(col[(t0 + k + 8) * 256]);
#pragma unroll 8
              for (int tt = 0; tt < 32; ++tt) { const int t = t0 + tt, r = row0 + t; int lo = r - hw, hi = lo + w; lo = lo < seq_lo ? seq_lo : lo; hi = hi > seq_hi ? seq_hi : hi;
                  PL[t * PL_LD + ch] = f2bf1(sum * __builtin_amdgcn_rcpf((float)(hi - lo)) - bf2f(col[(t + 8) * 256]));
                  sum += bf2f(col[(t + hw + 8) * 256]) - bf2f(col[(t - hw + 8) * 256]); } }
            __syncthreads();
#pragma unroll
            for (int mt = 0; mt < 2; ++mt) {
                const int t = th * 32 + mt * 16 + fr; bf16x8 Af[2];
#pragma unroll
                for (int ks = 0; ks < 2; ++ks) Af[ks] = *(const bf16x8*)(PL + t * PL_LD + g * 64 + 32 * ks + 8 * fq);
#pragma unroll
                for (int nt = 0; nt < 4; ++nt) { f32x4 acc = {0.f, 0.f, 0.f, 0.f};
#pragma unroll
                    for (int ks = 0; ks < 2; ++ks) acc = __builtin_amdgcn_mfma_f32_16x16x32_bf16(Wf[nt][ks], Af[ks], acc, 0, 0, 0);
                    acc = acc * pscv[nt]; u32x2 w; w.x = pk2(acc.x, acc.y); w.y = pk2(acc.z, acc.w);
                    *(u32x2*)(MIX + (size_t)(row0 + t) * DM + g * 64 + 16 * nt + 4 * fq) = w; } }
            __syncthreads();
        }
    }
    if (do_qk) {
        const int l32 = lane & 31, hw = lane >> 5; const float2* ROPE = (const float2*)(P.ws + WS_ROPE);
        const f32x4 kw = *(const f32x4*)(P.k_norm_w + l * 128 + 4 * l32);
        const int nxk = (NCHUNK > G && NCHUNK - G < G / 2) ? NCHUNK - G : 0; const int gw = bid >= nxk ? (bid - nxk) * 8 + wave : MROWS, NGW = (G - nxk) * 8;
        for (int m0 = gw; m0 < MROWS; m0 += 4 * NGW) {
            u32x2 raw[4];
#pragma unroll
            for (int q = 0; q < 4; ++q) { const int m = m0 + q * NGW; raw[q] = (u32x2){0u, 0u}; if (m < MROWS) raw[q] = *(const u32x2*)(U + (size_t)m * NU + 1536 + 128 * hw + 4 * l32); }
#pragma unroll
            for (int q = 0; q < 4; ++q) { const int m = m0 + q * NGW; if (m >= MROWS) continue;
                const int j = m % SEQU; const bool isc = j < CTXL; const int t = j - CTXL;
                const int pos = l32 < 16 ? (t >> 6) : (t & 63); const int ii = 4 * (l32 & 7);
                f32x4 cs = {1.f, 1.f, 1.f, 1.f}, sn = {0.f, 0.f, 0.f, 0.f};
                if (!isc) { const float2 r0 = ROPE[pos * 32 + ii], r1 = ROPE[pos * 32 + ii + 1], r2 = ROPE[pos * 32 + ii + 2], r3 = ROPE[pos * 32 + ii + 3];
                    cs = (f32x4){r0.x, r1.x, r2.x, r3.x}; sn = (f32x4){r0.y, r1.y, r2.y, r3.y}; }
                bf16u* p = U + (size_t)m * NU + 1536 + 128 * hw + 4 * l32;
                f32x4 v = {bflo(raw[q].x), bfhi(raw[q].x), bflo(raw[q].y), bfhi(raw[q].y)};
                float ss = (v.x * v.x + v.y * v.y) + (v.z * v.z + v.w * v.w);
#pragma unroll
                for (int o = 1; o < 32; o <<= 1) ss += bperm(ss, lane ^ o);
                const float rstd = rsqrtf(ss * (1.0f / 128.0f) + EPSN); v = (v * rstd) * kw;
                f32x4 pr; pr.x = bperm(v.x, lane ^ 8); pr.y = bperm(v.y, lane ^ 8); pr.z = bperm(v.z, lane ^ 8); pr.w = bperm(v.w, lane ^ 8);
                const f32x4 o = (l32 & 8) ? (pr * sn + v * cs) : (v * cs - pr * sn);
                u32x2 w; w.x = pk2(o.x, o.y); w.y = pk2(o.z, o.w); *(u32x2*)p = w; }
        }
    }
}

__device__ __forceinline__ void phase_scan(const Params& P, int tid, int G, const int bid) {
    const float* ST = (const float*)(P.ws + WS_ST); const float* CD = (const float*)(P.ws + WS_CD); bf16u* SP = (bf16u*)(P.ws + WS_SP);
    if (tid < 256)
    for (int e = bid * 256 + tid; e < 65536; e += G * 256) {
        const int combo = e >> 12, idx = e & 4095, b = combo >> 3, dh = combo & 7, d = dh >> 2; float S = 0.f;
        for (int s0 = 0; s0 < CPB; s0 += 10) { float stv[10], cdv[10]; size_t off[10];
#pragma unroll
            for (int q = 0; q < 10; ++q) { const int step = s0 + q; const int cb = d == 0 ? step : (step < 2 ? 1 - step : CPB + 1 - step); const int ci = b * CPB + cb;
                off[q] = (size_t)(ci * 8 + dh) * 4096 + idx; stv[q] = ST[off[q]]; cdv[q] = CD[ci * 8 + dh]; }
#pragma unroll
            for (int q = 0; q < 10; ++q) { SP[off[q]] = f2bf1(S); S = cdv[q] * S + stv[q]; } }
    }
}
#ifndef ATTN_DUP
#define ATTN_DUP 1
#endif
#ifndef ATTN_FIX_LIMIT
#define ATTN_FIX_LIMIT 60.0f
#endif
__device__ __forceinline__ void phase_attn(const Params& P, int l, unsigned char* lds, int G, const int tid, const int bid) {
    const att::bf16* U = (const att::bf16*)(P.ws + WS_U); att::bf16* MIX = (att::bf16*)(P.ws + WS_MIX);
    float mfix;
    { const int lane = tid & 63; const float* qw = P.q_norm_w + l * 128; const float* kw = P.k_norm_w + l * 128;
      float mq = fmaxf(fabsf(qw[lane]), fabsf(qw[lane + 64])), mk = fmaxf(fabsf(kw[lane]), fabsf(kw[lane + 64]));
#pragma unroll
      for (int o = 1; o < 64; o <<= 1) { mq = fmaxf(mq, bperm(mq, lane ^ o)); mk = fmaxf(mk, bperm(mk, lane ^ o)); }
      mfix = 128.0f * 1.001f * mq * mk * (att::SCALE * 1.4426950408889634f); }
    const bool has_cu = (l == 0 && (bid & 31) == 0 && (bid >> 5) < 8);
    if (mfix <= ATTN_FIX_LIMIT) {
#pragma unroll 1
    for (int u0 = has_cu ? -1 : (int)bid; u0 < 512 * ATTN_DUP; u0 = (u0 < 0 ? (int)bid : u0 + G)) {
        const int u = u0 < 0 ? u0 : (u0 & 511);
        size_t r0, rq; int h, kvh, seq;
        if (u < 0) { const int cu = bid >> 5; const int b = cu >> 2; h = cu & 3; kvh = h >> 1; r0 = (size_t)b * SEQU; rq = r0; seq = CTXL; }
        else { const int xcd = u & 7, slot = (u >> 3) & 31, i = u >> 8, combo = xcd >> 1, b = combo >> 1; kvh = combo & 1; h = 2 * kvh + (xcd & 1); const int qb = i * 32 + slot;
            r0 = (size_t)b * SEQU; rq = r0 + CTXL + (size_t)qb * 256; seq = SEQU; }
        att::attn_dense_body_dma<att::bf16>(U + rq * NU + 1024 + h * 128, U + r0 * NU + 1536 + kvh * 128, U + r0 * NU + 1792 + kvh * 128, MIX + rq * DM + 512 + h * 128, seq, (char*)lds, tid, P.q_norm_w + l * 128, (const float2*)(P.ws + WS_ROPE), u < 0 ? -1 : (int)(rq - r0 - CTXL));
        __syncthreads();
    }
    } else {
#pragma unroll 1
    for (int u0 = has_cu ? -1 : (int)bid; u0 < 512 * ATTN_DUP; u0 = (u0 < 0 ? (int)bid : u0 + G)) {
        const int u = u0 < 0 ? u0 : (u0 & 511);
        size_t r0, rq; int h, kvh, seq;
        if (u < 0) { const int cu = bid >> 5; const int b = cu >> 2; h = cu & 3; kvh = h >> 1; r0 = (size_t)b * SEQU; rq = r0; seq = CTXL; }
        else { const int xcd = u & 7, slot = (u >> 3) & 31, i = u >> 8, combo = xcd >> 1, b = combo >> 1; kvh = combo & 1; h = 2 * kvh + (xcd & 1); const int qb = i * 32 + slot;
            r0 = (size_t)b * SEQU; rq = r0 + CTXL + (size_t)qb * 256; seq = SEQU; }
        att::attn_dense_body<att::bf16, false>(U + rq * NU + 1024 + h * 128, U + r0 * NU + 1536 + kvh * 128, U + r0 * NU + 1792 + kvh * 128, MIX + rq * DM + 512 + h * 128, seq, (char*)lds, tid, P.q_norm_w + l * 128, (const float2*)(P.ws + WS_ROPE), u < 0 ? -1 : (int)(rq - r0 - CTXL));
        __syncthreads();
    }
    }
}

#ifndef SSD_STAGE_REP
#define SSD_STAGE_REP 1
#endif
#ifndef SSD_HEAD_REP
#define SSD_HEAD_REP 1
#endif
__device__ __forceinline__ void phase_ssdout(const Params& P, int l, unsigned char* lds, int tid, int lane, int wave, int G, const int bid) {
    const bf16u* U = (const bf16u*)(P.ws + WS_U); const bf16u* XBC = (const bf16u*)(P.ws + WS_XBC); bf16u* MIX = (bf16u*)(P.ws + WS_MIX); const bf16u* SP = (const bf16u*)(P.ws + WS_SP);
    bf16u* XT = (bf16u*)lds; float* ARR_dt = (float*)(lds + XT_BYTES); float* ARR_acs = (float*)(lds + XT_BYTES + 4096); bf16u* BC = (bf16u*)(lds + XT_BYTES + 8192);
    constexpr int BC_LD = 264;
    const int fr = lane & 15, fq = lane >> 4;
    for (int ci = bid; ci < NCHUNK; ci += G) {
        const int cb = ci % CPB, row0 = ci * 128; if (l == 1 && cb < 2) continue;
        (void)ssd_dt_arrays(P, l, row0, ARR_dt, ARR_acs, lane, wave);
        for (int _sr = 0; _sr < SSD_STAGE_REP; ++_sr) {
            const int cp = tid & 63, rg = tid >> 6;
#pragma unroll
            for (int k = 0; k < 2; ++k) { const int tb0 = 16 * rg + 8 * k; u32x4 w[8];
#pragma unroll
                for (int j = 0; j < 8; ++j) w[j] = *(const u32x4*)(XBC + (size_t)(row0 + tb0 + j) * 512 + 8 * cp);
                if (cp < 32) { bf16u* T = XT + xt_row(8 * cp) + tb0;
#pragma unroll
                    for (int c2 = 0; c2 < 4; ++c2) {
                        u32x4 lo, hi;
                        lo.x = (w[0][c2] & 0xffffu) | (w[1][c2] << 16); lo.y = (w[2][c2] & 0xffffu) | (w[3][c2] << 16); lo.z = (w[4][c2] & 0xffffu) | (w[5][c2] << 16); lo.w = (w[6][c2] & 0xffffu) | (w[7][c2] << 16);
                        hi.x = (w[0][c2] >> 16) | (w[1][c2] & 0xffff0000u); hi.y = (w[2][c2] >> 16) | (w[3][c2] & 0xffff0000u); hi.z = (w[4][c2] >> 16) | (w[5][c2] & 0xffff0000u); hi.w = (w[6][c2] >> 16) | (w[7][c2] & 0xffff0000u);
                        *(u32x4*)(T + (2 * c2) * XT_LD) = lo; *(u32x4*)(T + (2 * c2 + 1) * XT_LD) = hi; } }
                else {
#pragma unroll
                    for (int j = 0; j < 8; ++j) *(u32x4*)(BC + (size_t)(tb0 + j) * BC_LD + 8 * (cp - 32)) = w[j]; } }
        }
        __syncthreads();
        const int tau = 16 * wave + fr, r = row0 + tau;
        f32x4 Yp[4]; float ssq_p = 0.f;
#pragma unroll
        for (int pt = 0; pt < 4; ++pt) Yp[pt] = (f32x4){0.f, 0.f, 0.f, 0.f};
#pragma unroll 1
        for (int h0 = 0; h0 < 4 * SSD_HEAD_REP; ++h0) {
            const int h = h0 & 3, g = h >> 1;
            f32x4 Y[4];
#pragma unroll
            for (int pt = 0; pt < 4; ++pt) Y[pt] = (f32x4){0.f, 0.f, 0.f, 0.f};
            bf16x8 Cf[2];
            bf16x8 Sf[2][4][2];
#pragma unroll
            for (int d = 0; d < 2; ++d) { const bf16u* sp = SP + (size_t)(ci * 8 + d * 4 + h) * 4096 + fr * 64 + 8 * fq;
#pragma unroll
                for (int pt = 0; pt < 4; ++pt)
#pragma unroll
                    for (int ks = 0; ks < 2; ++ks) Sf[d][pt][ks] = *(const bf16x8*)(sp + (16 * pt) * 64 + 32 * ks); }
            const float dsk = P.d_skip[l * 8 + h] + P.d_skip[l * 8 + 4 + h];
            u32x2 xrv[4], zrv[4];
            { const bf16u* xrp = XBC + (size_t)r * 512 + h * 64 + 4 * fq; const bf16u* zrp = U + (size_t)r * NU + 256 + h * 64 + 4 * fq;
#pragma unroll
              for (int pt = 0; pt < 4; ++pt) { xrv[pt] = *(const u32x2*)(xrp + 16 * pt); zrv[pt] = *(const u32x2*)(zrp + 16 * pt); } }
            const bf16u* cp = BC + (size_t)tau * BC_LD + 128 + 64 * g + 8 * fq;
#pragma unroll
            for (int ks = 0; ks < 2; ++ks) Cf[ks] = *(const bf16x8*)(cp + 32 * ks);
            f32x4 Gm[8];
            const bf16u* bp = BC + (size_t)fr * BC_LD + 64 * g + 8 * fq;
#pragma unroll
            for (int nt = 0; nt < 8; ++nt) { Gm[nt] = (f32x4){0.f, 0.f, 0.f, 0.f};
#pragma unroll
                for (int ks = 0; ks < 2; ++ks) { const bf16x8 Bf = *(const bf16x8*)(bp + nt * 16 * BC_LD + 32 * ks);
                    Gm[nt] = __builtin_amdgcn_mfma_f32_16x16x32_bf16(Bf, Cf[ks], Gm[nt], 0, 0, 0); } }
            const float* acf = ARR_acs + h * 128; const float* acb = ARR_acs + (4 + h) * 128; const float* dtfp = ARR_dt + h * 128; const float* dtbp = ARR_dt + (4 + h) * 128;
            const float af_t = acf[tau], ab_t = acb[tau];
            int frl = fr; asm volatile("" : "+v"(frl));
            const bf16u* xtp = XT + xt_row(h * 64 + fr) + 4 * fq;
#pragma unroll
            for (int ks = 0; ks < 4; ++ks) {
                float mv[8];
#pragma unroll
                for (int hf = 0; hf < 2; ++hf) { const int nt = 2 * ks + hf, rho0 = 16 * nt + 4 * fq;
                    if (nt != wave) {
                        const bool lower = nt < wave; const float a_t = lower ? af_t : ab_t;
                        const f32x4 a_r = *(const f32x4*)((lower ? acf : acb) + rho0), dt_r = *(const f32x4*)((lower ? dtfp : dtbp) + rho0);
#pragma unroll
                        for (int i = 0; i < 4; ++i) mv[hf * 4 + i] = Gm[nt][i] * (__expf(a_t - a_r[i]) * dt_r[i]);
                    } else {
                        const f32x4 af_r = *(const f32x4*)(acf + rho0), ab_r = *(const f32x4*)(acb + rho0);
                        const f32x4 dtf = *(const f32x4*)(dtfp + rho0), dtb = *(const f32x4*)(dtbp + rho0);
#pragma unroll
                        for (int i = 0; i < 4; ++i) { const bool lw = (4 * fq + i) < frl;
                            const float arg = lw ? af_t - af_r[i] : ab_t - ab_r[i]; float f = __expf(arg) * (lw ? dtf[i] : dtb[i]);
                            if ((4 * fq + i) == frl) f = dtf[i] + dtb[i];
                            mv[hf * 4 + i] = Gm[nt][i] * f; }
                    } }
                u32x4 mw; mw.x = pk2(mv[0], mv[1]); mw.y = pk2(mv[2], mv[3]); mw.z = pk2(mv[4], mv[5]); mw.w = pk2(mv[6], mv[7]);
                const bf16x8 Mf = __builtin_bit_cast(bf16x8, mw);
#pragma unroll
                for (int pt = 0; pt < 4; ++pt) { const bf16u* xp = xtp + (16 * pt) * XT_LD + 2 * pt * 8 + 32 * ks;
                    const u32x2 x0 = *(const u32x2*)xp, x1 = *(const u32x2*)(xp + 16); const u32x4 xw = {x0.x, x0.y, x1.x, x1.y};
                    Y[pt] = __builtin_amdgcn_mfma_f32_16x16x32_bf16(__builtin_bit_cast(bf16x8, xw), Mf, Y[pt], 0, 0, 0); }
            }
#pragma unroll
            for (int d = 0; d < 2; ++d) {
                const float e = __expf(d == 0 ? af_t : ab_t);
#pragma unroll
                for (int pt = 0; pt < 4; ++pt) { f32x4 Z = {0.f, 0.f, 0.f, 0.f};
#pragma unroll
                    for (int ks = 0; ks < 2; ++ks) Z = __builtin_amdgcn_mfma_f32_16x16x32_bf16(Sf[d][pt][ks], Cf[ks], Z, 0, 0, 0);
                    Y[pt] += Z * e; }
            }
            float ssq = 0.f;
#pragma unroll
            for (int pt = 0; pt < 4; ++pt) {
                const u32x2 xr = xrv[pt], zr = zrv[pt];
                f32x4 y = Y[pt]; y.x += dsk * bflo(xr.x); y.y += dsk * bfhi(xr.x); y.z += dsk * bflo(xr.y); y.w += dsk * bfhi(xr.y);
                y.x *= siluf(bflo(zr.x)); y.y *= siluf(bfhi(zr.x)); y.z *= siluf(bflo(zr.y)); y.w *= siluf(bfhi(zr.y));
                Y[pt] = y; ssq += (y.x * y.x + y.y * y.y) + (y.z * y.z + y.w * y.w); }
            if ((h & 1) == 0) {
#pragma unroll
                for (int pt = 0; pt < 4; ++pt) Yp[pt] = Y[pt];
                ssq_p = ssq;
            } else {
                ssq += ssq_p; ssq += bperm(ssq, lane ^ 16); ssq += bperm(ssq, lane ^ 32); ssq = rsqrtf(ssq * (1.0f / 128.0f) + EPSN);
                const float* nwp = P.ssd_norm_w + l * 256 + (h - 1) * 64 + 4 * fq; bf16u* op = MIX + (size_t)r * DM + 256 + (h - 1) * 64 + 4 * fq;
#pragma unroll
                for (int pt = 0; pt < 4; ++pt) { const f32x4 o0 = Yp[pt] * ssq * *(const f32x4*)(nwp + 16 * pt), o1 = Y[pt] * ssq * *(const f32x4*)(nwp + 64 + 16 * pt);
                    u32x2 w0, w1; w0.x = pk2(o0.x, o0.y); w0.y = pk2(o0.z, o0.w); w1.x = pk2(o1.x, o1.y); w1.y = pk2(o1.z, o1.w);
                    *(u32x2*)(op + 16 * pt) = w0; *(u32x2*)(op + 64 + 16 * pt) = w1; }
            }
        }
        __syncthreads();
    }
}


template <int K, class RT, class OT>
__device__ __forceinline__ void ctx_gemm_resid(const bf16u* A  , const bf16u* Wt  , const RT* res_ctx, OT* out_ctx, const float* gate_ctx,
                                               unsigned char* lds, int tid, int lane, int wave, int G, int bid) {
    constexpr int KW = K / 8, PLD = 68; static_assert(KW % 32 == 0, "K/8 must be a multiple of the MFMA k-step");
    const int fr = lane & 15, fq = lane >> 4; float* PS = (float*)lds;
    for (int it = bid; it < 128; it += G) {
        const int mt = it >> 4, nt64 = it & 15;
        const bf16u* ap[4]; const bf16u* bp[4];
#pragma unroll
        for (int q = 0; q < 4; ++q) { const int c = mt * 64 + q * 16 + fr;
            ap[q] = A + ((size_t)(c >> 8) * SEQU + (c & 255)) * K + wave * KW + 8 * fq;
            bp[q] = Wt + (size_t)(nt64 * 64 + q * 16 + fr) * K + wave * KW + 8 * fq; }
        f32x4 acc[4][4];
#pragma unroll
        for (int mi = 0; mi < 4; ++mi)
#pragma unroll
            for (int ni = 0; ni < 4; ++ni) acc[mi][ni] = (f32x4){0.f, 0.f, 0.f, 0.f};
#pragma unroll 4
        for (int k = 0; k < KW; k += 32) { bf16x8 af[4], bfr[4];
#pragma unroll
            for (int q = 0; q < 4; ++q) { af[q] = *(const bf16x8*)(ap[q] + k); bfr[q] = *(const bf16x8*)(bp[q] + k); }
#pragma unroll
            for (int mi = 0; mi < 4; ++mi)
#pragma unroll
                for (int ni = 0; ni < 4; ++ni) acc[mi][ni] = __builtin_amdgcn_mfma_f32_16x16x32_bf16(bfr[ni], af[mi], acc[mi][ni], 0, 0, 0); }
#pragma unroll
        for (int mi = 0; mi < 4; ++mi)
#pragma unroll
            for (int ni = 0; ni < 4; ++ni) *(f32x4*)(PS + (size_t)(wave * 64 + 16 * mi + fr) * PLD + 16 * ni + 4 * fq) = acc[mi][ni];
        __syncthreads();
        { const int row = tid >> 3, c8 = (tid & 7) * 8; f32x4 s0 = {0.f, 0.f, 0.f, 0.f}, s1 = s0;
#pragma unroll
          for (int w = 0; w < 8; ++w) { s0 += *(const f32x4*)(PS + (size_t)(w * 64 + row) * PLD + c8); s1 += *(const f32x4*)(PS + (size_t)(w * 64 + row) * PLD + c8 + 4); }
          const int col = nt64 * 64 + c8; const size_t o = (size_t)(mt * 64 + row) * DM + col; f32x4 r0, r1; pg8::ld8(res_ctx + o, r0, r1);
          pg8::st8(out_ctx + o, r0 + *(const f32x4*)(gate_ctx + col) * s0, r1 + *(const f32x4*)(gate_ctx + col + 4) * s1); }
        __syncthreads();
    }
}

__device__ __forceinline__ void ctx_up_swiglu(const bf16u* HN  , const bf16u* W13  , bf16u* ACT,
                                              unsigned char* lds, int tid, int lane, int wave, int G, int bid) {
    constexpr int KW = DM / 8, PLD = 68;
    const int fr = lane & 15, fq = lane >> 4; float* PS = (float*)lds;
    for (int it = bid; it < 8 * 22 * 4; it += G) {
        const int mt = it / 88, r = it % 88, pn = r >> 2, sb = r & 3;
        const bf16u* ap[4]; const bf16u* bp[4];
#pragma unroll
        for (int q = 0; q < 4; ++q) { const int c = mt * 64 + q * 16 + fr;
            ap[q] = HN + ((size_t)(c >> 8) * SEQU + (c & 255)) * DM + wave * KW + 8 * fq;
            bp[q] = W13 + (size_t)(256 * pn + (q >> 1) * 128 + 32 * sb + 16 * (q & 1) + fr) * DM + wave * KW + 8 * fq; }
        f32x4 acc[4][4];
#pragma unroll
        for (int mi = 0; mi < 4; ++mi)
#pragma unroll
            for (int ni = 0; ni < 4; ++ni) acc[mi][ni] = (f32x4){0.f, 0.f, 0.f, 0.f};
#pragma unroll
        for (int k = 0; k < KW; k += 32) { bf16x8 af[4], bfr[4];
#pragma unroll
            for (int q = 0; q < 4; ++q) { af[q] = *(const bf16x8*)(ap[q] + k); bfr[q] = *(const bf16x8*)(bp[q] + k); }
#pragma unroll
            for (int mi = 0; mi < 4; ++mi)
#pragma unroll
                for (int ni = 0; ni < 4; ++ni) acc[mi][ni] = __builtin_amdgcn_mfma_f32_16x16x32_bf16(bfr[ni], af[mi], acc[mi][ni], 0, 0, 0); }
#pragma unroll
        for (int mi = 0; mi < 4; ++mi)
#pragma unroll
            for (int ni = 0; ni < 4; ++ni) *(f32x4*)(PS + (size_t)(wave * 64 + 16 * mi + fr) * PLD + 16 * ni + 4 * fq) = acc[mi][ni];
        __syncthreads();
        if (tid < 256) { const int row = tid >> 2, f8 = (tid & 3) * 8; f32x4 g0 = {0.f, 0.f, 0.f, 0.f}, g1 = g0, u0 = g0, u1 = g0;
#pragma unroll
            for (int w = 0; w < 8; ++w) { const float* p = PS + (size_t)(w * 64 + row) * PLD + f8;
                g0 += *(const f32x4*)p; g1 += *(const f32x4*)(p + 4); u0 += *(const f32x4*)(p + 32); u1 += *(const f32x4*)(p + 36); }
            const int c = mt * 64 + row; u32x4 wv;
            wv.x = pk2(pg8::EpiSwiGLU::sw(g0.x, u0.x), pg8::EpiSwiGLU::sw(g0.y, u0.y)); wv.y = pk2(pg8::EpiSwiGLU::sw(g0.z, u0.z), pg8::EpiSwiGLU::sw(g0.w, u0.w));
            wv.z = pk2(pg8::EpiSwiGLU::sw(g1.x, u1.x), pg8::EpiSwiGLU::sw(g1.y, u1.y)); wv.w = pk2(pg8::EpiSwiGLU::sw(g1.z, u1.z), pg8::EpiSwiGLU::sw(g1.w, u1.w));
            *(u32x4*)(ACT + ((size_t)(c >> 8) * SEQU + (c & 255)) * DFF + 128 * pn + 32 * sb + f8) = wv; }
        __syncthreads();
    }
}

#define LAS __attribute__((address_space(3)))
#define XB_TMO      128
#define XB_XCNT(j)  (256  + 64 * (j))
#define XB_XSUB(j)  (1280 + 64 * (j))
#define XB_XGEN(j)  (2304 + 64 * (j))
#define XB_TOP      3328
#define XB_TOPGEN   3392
#define XCD_BAR_WORDS 3456
#define XB_SPIN_CAP (1u << 18)

__device__ __forceinline__ unsigned xb_ld(unsigned* p)              { return __hip_atomic_load(p, __ATOMIC_RELAXED, __HIP_MEMORY_SCOPE_AGENT); }
__device__ __forceinline__ unsigned xb_add(unsigned* p, unsigned v) { return __hip_atomic_fetch_add(p, v, __ATOMIC_RELAXED, __HIP_MEMORY_SCOPE_AGENT); }
__device__ __forceinline__ unsigned xb_xcc_id() { return (unsigned)__builtin_amdgcn_s_getreg((3 << 11) | 20) & 0xFu; }
#define XB_SPIN(cond, bar) do { unsigned _sp = 0; while (cond) { __builtin_amdgcn_s_sleep(1); \
    if ((++_sp & 255u) == 0u) { if (xb_ld(&(bar)[XB_TMO])) break; if (_sp > XB_SPIN_CAP) { atomicAdd(&(bar)[XB_TMO], 1u); break; } } } } while (0)

struct XcdBarrier {
    unsigned* bar; unsigned x;
    volatile LAS unsigned* st;
};

__device__ __forceinline__ XcdBarrier xcd_barrier_post(unsigned* bar, volatile LAS unsigned* st, const int tid_) {
    XcdBarrier b; b.bar = bar; b.x = xb_xcc_id(); b.st = st;
    if (tid_ == 0) (void)xb_add(&bar[XB_XCNT(b.x)], 1u);
    return b;
}
__device__ __forceinline__ void xcd_barrier_complete(unsigned* bar, unsigned x, unsigned& nloc, unsigned& nx) {
    const unsigned G = gridDim.x * gridDim.y * gridDim.z;
    unsigned sum, cnt, mine, sp = 0u;
    for (;;) {
        sum = 0u; cnt = 0u; mine = 0u;
#pragma unroll
        for (unsigned j = 0; j < 16; ++j) { const unsigned c = xb_ld(&bar[XB_XCNT(j)]); sum += c; cnt += (c > 0u) ? 1u : 0u; mine = (j == x) ? c : mine; }
        if (sum == G) break;
        __builtin_amdgcn_s_sleep(1);
        if ((++sp & 255u) == 0u) { if (xb_ld(&bar[XB_TMO])) break; if (sp > XB_SPIN_CAP) { atomicAdd(&bar[XB_TMO], 1u); break; } }
    }
    nloc = mine > 0u ? mine : 1u; nx = cnt > 0u ? cnt : 1u;
}

__device__ __forceinline__ void xcd_barrier(const XcdBarrier& b, const int tid_) {
    asm volatile("s_waitcnt vmcnt(0)" ::: "memory");
    __syncthreads();
    if (tid_ == 0) {
        unsigned* bar = b.bar;
        __builtin_amdgcn_s_waitcnt(0);
        unsigned nloc = b.st[0], nx = b.st[1];
        if (nloc == 0u) { xcd_barrier_complete(bar, b.x, nloc, nx); b.st[0] = nloc; b.st[1] = nx; }
        const unsigned old = xb_add(&bar[XB_XSUB(b.x)], 1u);
        const unsigned gen = old / nloc;
        if (old + 1u == (gen + 1u) * nloc) {
            __builtin_amdgcn_fence(__ATOMIC_RELEASE, "agent");
            asm volatile("s_waitcnt vmcnt(0)" ::: "memory");
            const unsigned og = xb_add(&bar[XB_TOP], 1u);
            const unsigned tg = og / nx;
            if (og + 1u == (tg + 1u) * nx) xb_add(&bar[XB_TOPGEN], 1u);
            else XB_SPIN(xb_ld(&bar[XB_TOPGEN]) == tg, bar);
            __builtin_amdgcn_fence(__ATOMIC_ACQUIRE, "agent");
            xb_add(&bar[XB_XGEN(b.x)], 1u);
            asm volatile("s_waitcnt vmcnt(0)" ::: "memory");
        } else {
            XB_SPIN(xb_ld(&bar[XB_XGEN(b.x)]) == gen, bar);
            __builtin_amdgcn_fence(__ATOMIC_ACQUIRE, "agent");
            asm volatile("s_waitcnt vmcnt(0)" ::: "memory");
        }
    }
    __syncthreads();
}

typedef unsigned long long u64t;
__device__ __forceinline__ u64t ld_tab(const __attribute__((address_space(3))) u64t* T, int i) { const u64t v = T[i];
    return (u64t)(unsigned)__builtin_amdgcn_readfirstlane((int)(unsigned)v) | ((u64t)(unsigned)__builtin_amdgcn_readfirstlane((int)(unsigned)(v >> 32)) << 32); }
#define GLB(T, v) ((T*)(__attribute__((address_space(1))) T*)(v))
__device__ __forceinline__ Params load_params(const __attribute__((address_space(3))) u64t* T, int lo, int hi) {
    Params Q;
    Q.x = GLB(const float, ld_tab(T, 0)); Q.c = GLB(const float, ld_tab(T, 1)); Q.ctx = GLB(const float, ld_tab(T, 2)); Q.c_ctx = GLB(const float, ld_tab(T, 3)); Q.norm1_w = GLB(const float, ld_tab(T, 4));
    Q.norm2_w = GLB(const float, ld_tab(T, 5)); Q.w_mod = GLB(const float, ld_tab(T, 6)); Q.b_mod = GLB(const float, ld_tab(T, 7)); Q.w_in = GLB(const float, ld_tab(T, 8)); Q.pool_w = GLB(const float, ld_tab(T, 9));
    Q.pool_scale = GLB(const float, ld_tab(T, 10)); Q.conv_w = GLB(const float, ld_tab(T, 11)); Q.conv_b = GLB(const float, ld_tab(T, 12)); Q.dt_bias = GLB(const float, ld_tab(T, 13)); Q.a_log = GLB(const float, ld_tab(T, 14));
    Q.d_skip = GLB(const float, ld_tab(T, 15)); Q.ssd_norm_w = GLB(const float, ld_tab(T, 16)); Q.q_norm_w = GLB(const float, ld_tab(T, 17)); Q.k_norm_w = GLB(const float, ld_tab(T, 18)); Q.w_out = GLB(const float, ld_tab(T, 19));
    Q.w1 = GLB(const float, ld_tab(T, 20)); Q.w3 = GLB(const float, ld_tab(T, 21)); Q.w2 = GLB(const float, ld_tab(T, 22)); Q.out = GLB(float, ld_tab(T, 23)); Q.ws = GLB(unsigned char, ld_tab(T, 24)); Q.ph_lo = lo; Q.ph_hi = hi;
    return Q;
}
__global__ void __launch_bounds__(512, 2) hybrid_fwd(Params P0) {
    extern __shared__ __attribute__((aligned(16))) unsigned char lds[];
    cg::grid_group grid = cg::this_grid();
    PG8_LAS unsigned char* ldsl = (PG8_LAS unsigned char*)lds;
    PG8_LAS u64t* TAB = (PG8_LAS u64t*)(ldsl + LDS_TAB);
    const int lo = P0.ph_lo, hi = P0.ph_hi;
    const int wave0 = __builtin_amdgcn_readfirstlane((int)threadIdx.x >> 6);
#define FRESH_TID(name) unsigned name##z_ = 0u; asm volatile("" : "+s"(name##z_)); int name = wave0 * 64 + (int)__builtin_amdgcn_mbcnt_hi(~0u, __builtin_amdgcn_mbcnt_lo(~0u, name##z_)); asm volatile("" : "+v"(name));
    if (threadIdx.x == 0) {
        TAB[0] = (u64t)P0.x; TAB[1] = (u64t)P0.c; TAB[2] = (u64t)P0.ctx; TAB[3] = (u64t)P0.c_ctx; TAB[4] = (u64t)P0.norm1_w; TAB[5] = (u64t)P0.norm2_w; TAB[6] = (u64t)P0.w_mod; TAB[7] = (u64t)P0.b_mod;
        TAB[8] = (u64t)P0.w_in; TAB[9] = (u64t)P0.pool_w; TAB[10] = (u64t)P0.pool_scale; TAB[11] = (u64t)P0.conv_w; TAB[12] = (u64t)P0.conv_b; TAB[13] = (u64t)P0.dt_bias; TAB[14] = (u64t)P0.a_log;
        TAB[15] = (u64t)P0.d_skip; TAB[16] = (u64t)P0.ssd_norm_w; TAB[17] = (u64t)P0.q_norm_w; TAB[18] = (u64t)P0.k_norm_w; TAB[19] = (u64t)P0.w_out; TAB[20] = (u64t)P0.w1; TAB[21] = (u64t)P0.w3;
        TAB[22] = (u64t)P0.w2; TAB[23] = (u64t)P0.out; TAB[24] = (u64t)P0.ws;
        ((PG8_LAS unsigned*)(ldsl + LDS_TAB + 256))[0] = 0u; ((PG8_LAS unsigned*)(ldsl + LDS_TAB + 256))[1] = 0u;
    }
    __syncthreads();
    if (blockIdx.x == 0) { for (int i = threadIdx.x; i < 4096; i += 512) ((unsigned*)(P0.ws + WS_BAR))[i] = 0u; }
    XcdBarrier bar; bar.bar = (unsigned*)(P0.ws + WS_BAR); bar.x = 0; bar.st = (volatile LAS unsigned*)(ldsl + LDS_TAB + 256);
#ifndef TMASK
#define TMASK 0xFFFF
#endif
#define EN(t) (((TMASK) >> (t)) & 1)
#ifndef DUPMASK
#define DUPMASK 0
#endif
#ifndef DUPMASK0
#define DUPMASK0 DUPMASK
#endif
#ifndef DUPMASK1
#define DUPMASK1 DUPMASK
#endif
#define NREP(t) (((((l_ == 0 ? (DUPMASK0) : (DUPMASK1))) >> (t)) & 1) ? 2 : 1)
#define IN(k) (lo <= (k) && (k) < hi)
#ifndef SCAN_DUP
#define SCAN_DUP 1
#endif
#ifndef BAR_DUP
#define BAR_DUP 1
#endif
#define SEAM(k) do { if (IN(k) && IN((k) + 1)) { if ((k) == 0) { grid.sync(); FRESH_TID(tb_); bar = xcd_barrier_post(bar.bar, bar.st, tb_); } else { FRESH_TID(tb_); for (int _b = 0; _b < BAR_DUP; ++_b) xcd_barrier(bar, tb_); } } } while (0)
#define FRESH() FRESH_TID(tid) int bid = blockIdx.x; asm volatile("" : "+s"(bid)); int G = gridDim.x; asm volatile("" : "+s"(G)); const int lane = tid & 63, wave = __builtin_amdgcn_readfirstlane(tid >> 6); (void)lane; (void)wave; \
    const Params P = load_params(TAB, lo, hi); unsigned char* const ws = P.ws; (void)ws;
    constexpr int l_ = 0;
    if (EN(0) && IN(0)) { for (int rep = 0; rep < NREP(0); ++rep) { FRESH(); phase_prep(P, lds, tid, lane, wave, G, bid); } } SEAM(0);
    if (EN(1) && IN(1)) { for (int rep = 0; rep < NREP(1); ++rep) { FRESH(); phase_modreduce(P, tid, G, bid); } } SEAM(1);
    { constexpr int l = 0; constexpr int l_ = 0;
        const int pb = 2 + 9 * l; const int skip = l;
#define LAYER_PTRS() const float* mod = (const float*)(ws + WS_MOD) + (size_t)l * 3 * NMODV; (void)mod; \
        bf16u* XSL = (bf16u*)(ws + WS_XSL); bf16u* XSC = (bf16u*)(ws + WS_XSC); (void)XSL; (void)XSC; bf16u* HN = (bf16u*)(ws + WS_HN); (void)HN;
        if (EN(2) && IN(pb + 0)) { for (int rep = 0; rep < NREP(2); ++rep) { FRESH(); LAYER_PTRS(); phase_norm<float>(P.x, P.ctx, P.norm1_w + l * DM, mod, 0, 1024, HN, 0, lane, wave, G, bid); } } SEAM(pb + 0);
        if (EN(3) && IN(pb + 1)) { for (int rep = 0; rep < NREP(3); ++rep) { FRESH(); LAYER_PTRS(); pg8::Gemm g{HN, (const bf16u*)(ws + WS_WIN) + (size_t)l * NIN * 1024, MROWS, NIN, DM}; pg8::OrderX S; S.init(MROWS / 256, NIN, G, bid, 0);
            pg8::EpiInProj E{(bf16u*)(ws + WS_U), (float*)(ws + WS_DT)};
            pg8::gemm_phase<pg8::EpiInProj, pg8::OrderX, true, true>(ldsl, g, S, E, tid);
            { const int nwg = 130 * 9, R = (nwg + G - 1) / G, fi = nwg - (R - 1) * G;
              if (nwg % G == 0) prep_layer1_weights(P, lds, lane, wave, bid, G); else if (bid >= fi) prep_layer1_weights(P, lds, lane, wave, bid - fi, G - fi); } } } SEAM(pb + 1);
        if (EN(4) && IN(pb + 2)) { for (int rep = 0; rep < NREP(4); ++rep) { FRESH(); phase_mixprep(P, l, lds, tid, lane, wave, G, bid, rep == NREP(4) - 1); } } SEAM(pb + 2);
        if (EN(5) && IN(pb + 3)) { for (int rep = 0; rep < NREP(5); ++rep) { { FRESH(); for (int _s = 0; _s < SCAN_DUP; ++_s) phase_scan(P, tid, G, bid); } __syncthreads(); { FRESH(); phase_attn(P, l, lds, G, tid, bid); } } } SEAM(pb + 3);
        if (EN(6) && IN(pb + 4)) { for (int rep = 0; rep < NREP(6); ++rep) { FRESH(); phase_ssdout(P, l, lds, tid, lane, wave, G, bid); } } SEAM(pb + 4);
        if (EN(7) && IN(pb + 5)) { for (int rep = 0; rep < NREP(7); ++rep) { FRESH(); LAYER_PTRS(); if (l == 0) { ctx_gemm_resid<DM, float, bf16u>((const bf16u*)(ws + WS_MIX), (const bf16u*)(ws + WS_WOUT), P.ctx, XSC, mod + 2048 + 2 * NMODV, lds, tid, lane, wave, G, bid); __syncthreads(); }
            pg8::Gemm g{(const bf16u*)(ws + WS_MIX), (const bf16u*)(ws + WS_WOUT) + (size_t)l * 1024 * 1024, MROWS, DM, DM}; pg8::OrderX S; S.init(128, DM, G, bid, 1);
            pg8::EpiResid<float, bf16u> E{P.x, P.ctx, XSL, XSC, mod + 2048};
            pg8::gemm_phase<pg8::EpiResid<float, bf16u>, pg8::OrderX, true, true>(ldsl, g, S, E, tid); } } SEAM(pb + 5);
        if (EN(8) && IN(pb + 6)) { for (int rep = 0; rep < NREP(8); ++rep) { FRESH(); LAYER_PTRS(); phase_norm<bf16u>(XSL, XSC, P.norm2_w + l * DM, mod, 3072, 4096, HN, skip, lane, wave, G, bid); } } SEAM(pb + 6);
        if (EN(9) && IN(pb + 7)) { for (int rep = 0; rep < NREP(9); ++rep) { FRESH(); LAYER_PTRS(); ctx_up_swiglu(HN, (const bf16u*)(ws + WS_W13), (bf16u*)(ws + WS_ACT), lds, tid, lane, wave, G, bid); __syncthreads();
            pg8::Gemm g{HN, (const bf16u*)(ws + WS_W13) + (size_t)l * 2 * DFF * 1024, MROWS, 2 * DFF, DM}; pg8::OrderX S; S.init(128, 2 * DFF, G, bid, 1);
            pg8::EpiSwiGLU E{(bf16u*)(ws + WS_ACT)};
            pg8::gemm_phase<pg8::EpiSwiGLU, pg8::OrderX, true, true>(ldsl, g, S, E, tid); } } SEAM(pb + 7);
        if (EN(10) && IN(pb + 8)) { for (int rep = 0; rep < NREP(10); ++rep) { FRESH(); LAYER_PTRS(); if (l == 0) { ctx_gemm_resid<DFF, bf16u, bf16u>((const bf16u*)(ws + WS_ACT), (const bf16u*)(ws + WS_W2), XSC, XSC, mod + 5120 + 2 * NMODV, lds, tid, lane, wave, G, bid); __syncthreads(); }
            pg8::Gemm g{(const bf16u*)(ws + WS_ACT), (const bf16u*)(ws + WS_W2) + (size_t)l * 1024 * DFF, MROWS, DM, DFF}; pg8::OrderX S; S.init(128, DM, G, bid, 1);
            pg8::EpiResid<bf16u, bf16u> E{XSL, XSC, XSL, XSC, mod + 5120};
            pg8::gemm_phase<pg8::EpiResid<bf16u, bf16u>, pg8::OrderX, true, true>(ldsl, g, S, E, tid); } } SEAM(pb + 8);
        }
    { constexpr int l = 1; constexpr int l_ = 1;
        const int pb = 2 + 9 * l; const int skip = l;
#undef LAYER_PTRS
#define LAYER_PTRS() const float* mod = (const float*)(ws + WS_MOD) + (size_t)l * 3 * NMODV; (void)mod; \
        bf16u* XSL = (bf16u*)(ws + WS_XSL); bf16u* XSC = (bf16u*)(ws + WS_XSC); (void)XSL; (void)XSC; bf16u* HN = (bf16u*)(ws + WS_HN); (void)HN;
        if (EN(2) && IN(pb + 0)) { for (int rep = 0; rep < NREP(2); ++rep) { FRESH(); LAYER_PTRS(); phase_norm<bf16u>(XSL, XSC, P.norm1_w + l * DM, mod, 0, 1024, HN, 0, lane, wave, G, bid); } } SEAM(pb + 0);
        if (EN(3) && IN(pb + 1)) { for (int rep = 0; rep < NREP(3); ++rep) { FRESH(); LAYER_PTRS(); pg8::Gemm g{HN, (const bf16u*)(ws + WS_WIN) + (size_t)l * NIN * 1024, MROWS, NIN, DM}; pg8::OrderX S; S.init(MROWS / 256, NIN, G, bid, 0);
            pg8::EpiInProj E{(bf16u*)(ws + WS_U), (float*)(ws + WS_DT)};
            pg8::gemm_phase<pg8::EpiInProj, pg8::OrderX, true, true>(ldsl, g, S, E, tid); } } SEAM(pb + 1);
        if (EN(4) && IN(pb + 2)) { for (int rep = 0; rep < NREP(4); ++rep) { FRESH(); phase_mixprep(P, l, lds, tid, lane, wave, G, bid, rep == NREP(4) - 1); } } SEAM(pb + 2);
        if (EN(5) && IN(pb + 3)) { for (int rep = 0; rep < NREP(5); ++rep) { { FRESH(); for (int _s = 0; _s < SCAN_DUP; ++_s) phase_scan(P, tid, G, bid); } __syncthreads(); { FRESH(); phase_attn(P, l, lds, G, tid, bid); } } } SEAM(pb + 3);
        if (EN(6) && IN(pb + 4)) { for (int rep = 0; rep < NREP(6); ++rep) { FRESH(); phase_ssdout(P, l, lds, tid, lane, wave, G, bid); } } SEAM(pb + 4);
        if (EN(7) && IN(pb + 5)) { for (int rep = 0; rep < NREP(7); ++rep) { FRESH(); LAYER_PTRS(); if (l == 0) { ctx_gemm_resid<DM, bf16u, bf16u>((const bf16u*)(ws + WS_MIX), (const bf16u*)(ws + WS_WOUT), XSC, XSC, mod + 2048 + 2 * NMODV, lds, tid, lane, wave, G, bid); __syncthreads(); }
            pg8::Gemm g{(const bf16u*)(ws + WS_MIX), (const bf16u*)(ws + WS_WOUT) + (size_t)l * 1024 * 1024, MROWS, DM, DM}; pg8::OrderX S; S.init(128, DM, G, bid, 1);
            pg8::EpiResid<bf16u, bf16u> E{XSL, XSC, XSL, XSC, mod + 2048};
            pg8::gemm_phase<pg8::EpiResid<bf16u, bf16u>, pg8::OrderX, true, true>(ldsl, g, S, E, tid); } } SEAM(pb + 5);
        if (EN(8) && IN(pb + 6)) { for (int rep = 0; rep < NREP(8); ++rep) { FRESH(); LAYER_PTRS(); phase_norm<bf16u>(XSL, XSC, P.norm2_w + l * DM, mod, 3072, 4096, HN, skip, lane, wave, G, bid); } } SEAM(pb + 6);
        if (EN(9) && IN(pb + 7)) { for (int rep = 0; rep < NREP(9); ++rep) { FRESH(); LAYER_PTRS(); pg8::Gemm g{HN, (const bf16u*)(ws + WS_W13) + (size_t)l * 2 * DFF * 1024, MROWS, 2 * DFF, DM}; pg8::OrderX S; S.init(skip ? 128 : 130, 2 * DFF, G, bid, skip);
            pg8::EpiSwiGLU E{(bf16u*)(ws + WS_ACT)};
            pg8::gemm_phase<pg8::EpiSwiGLU, pg8::OrderX, true, true>(ldsl, g, S, E, tid); } } SEAM(pb + 7);
        if (EN(10) && IN(pb + 8)) { for (int rep = 0; rep < NREP(10); ++rep) { FRESH(); LAYER_PTRS(); if (l == 0) { ctx_gemm_resid<DFF, bf16u, bf16u>((const bf16u*)(ws + WS_ACT), (const bf16u*)(ws + WS_W2), XSC, XSC, mod + 5120 + 2 * NMODV, lds, tid, lane, wave, G, bid); __syncthreads(); }
            pg8::Gemm g{(const bf16u*)(ws + WS_ACT), (const bf16u*)(ws + WS_W2) + (size_t)l * 1024 * DFF, MROWS, DM, DFF}; pg8::OrderX S; S.init(128, DM, G, bid, 1);
            pg8::EpiResid<bf16u, float> E{XSL, XSC, P.out, P.out, mod + 5120};
            pg8::gemm_phase<pg8::EpiResid<bf16u, float>, pg8::OrderX, true, true>(ldsl, g, S, E, tid); } } SEAM(pb + 8);
        }
#undef IN
#undef SEAM
}

#ifndef MK_PER_PHASE
#define MK_PER_PHASE 0
#endif
extern "C" void kernel_launch(void* const* d_in, const int* in_sizes, int n_in, void* d_out, int out_size, void* d_ws, size_t ws_size, hipStream_t stream) {
    static int grid = 0;
    if (grid == 0) {
        if (n_in != 23 || in_sizes[0] != NBATCH * LSEQ * DM || out_size != NBATCH * LSEQ * DM || ws_size < WS_END) {
            fprintf(stderr, "kernel_launch: unexpected shapes (n_in %d, in0 %d, out %d, ws %zu)\n", n_in, n_in > 0 ? in_sizes[0] : -1, out_size, ws_size); grid = -1; return; }
        int dev = 0, cus = 0, per_cu = 0;
        (void)hipGetDevice(&dev); (void)hipDeviceGetAttribute(&cus, hipDeviceAttributeMultiprocessorCount, dev);
        if (hipFuncSetAttribute((const void*)hybrid_fwd, hipFuncAttributeMaxDynamicSharedMemorySize, LDS_BYTES) != hipSuccess) { fprintf(stderr, "kernel_launch: hipFuncSetAttribute failed\n"); grid = -1; return; }
        if (hipOccupancyMaxActiveBlocksPerMultiprocessor(&per_cu, (const void*)hybrid_fwd, 512, LDS_BYTES) != hipSuccess || per_cu < 1) { fprintf(stderr, "kernel_launch: occupancy query gives %d\n", per_cu); per_cu = 1; }
        (void)hipGetLastError();
        grid = cus * (per_cu > 1 ? 1 : per_cu);
        if (grid <= 0) grid = 256;
    }
    if (grid < 0) return;
    Params p{};
    const float** pp = (const float**)&p;
    for (int i = 0; i < 23; ++i) pp[i] = (const float*)d_in[i];
    p.out = (float*)d_out; p.ws = (unsigned char*)d_ws;
#if MK_PER_PHASE
    for (int ph = 0; ph < NPHASE; ++ph) { p.ph_lo = ph; p.ph_hi = ph + 1; hipLaunchKernelGGL(hybrid_fwd, dim3(grid), dim3(512), LDS_BYTES, stream, p); }
#else
    p.ph_lo = 0; p.ph_hi = NPHASE;
    void* args[] = {&p};
    hipError_t e = hipLaunchCooperativeKernel((const void*)hybrid_fwd, dim3(grid), dim3(512), args, LDS_BYTES, stream);
    if (e != hipSuccess) fprintf(stderr, "kernel_launch: cooperative launch failed: %s (grid %d)\n", hipGetErrorString(e), grid);
#endif
}
```

```cpp
#include <hip/hip_runtime.h>
#include <hip/hip_bf16.h>
#include <hip/hip_cooperative_groups.h>
#include <cstdio>
#include <cstdint>
namespace cg = cooperative_groups;


namespace pg8 {
#define PG8_LAS __attribute__((address_space(3)))
typedef unsigned short bf16_t;
typedef short bf16x8 __attribute__((ext_vector_type(8)));
typedef float f32x4 __attribute__((ext_vector_type(4)));
typedef unsigned u32x4 __attribute__((ext_vector_type(4)));
constexpr int BM = 256, BK = 64, HALF = 128, HTB = HALF * BK * 2  , STAGE_BYTES = 8 * HTB, NXCD = 8, WGM = 8;

__host__ __device__ __forceinline__ int lds_byte(int r, int c) { const int st = (r >> 4) * 2 + (c >> 5), rr = r & 15, cc = c & 31, ob = rr * 64 + cc * 2; return st * 1024 + (ob ^ (((ob >> 9) & 1) << 5)); }
__host__ __device__ __forceinline__ void stage_rc(int b, int& R, int& C) { const int st = b / 1024, sb = b % 1024, swz = sb ^ (((sb >> 9) & 1) << 5); R = (st >> 1) * 16 + swz / 64; C = (st & 1) * 32 + (swz % 64) / 2; }
__host__ __device__ __forceinline__ int perm32(int rho) { const int n = rho >> 4, i = rho & 15; return 8 * (i >> 2) + 4 * n + (i & 3); }

struct Unit { int pm, pn; };
struct Gemm { const bf16_t* A; const bf16_t* Bt; int M, N, K; };

struct StaticOrder {
    int nM, nN, nwg, G, c;
    __host__ __device__ void init(int M, int N, int G_, int c_) { nM = M / BM; nN = N / BM; nwg = nM * nN; G = G_; c = c_; }
    __host__ __device__ bool next(int i, Unit& u) const {
        const long L = (long)i * G + c; if (L >= nwg) return false;
        int wgid = (int)L; { const int q = nwg / NXCD, r = nwg % NXCD, xcd = wgid % NXCD, off = wgid / NXCD; wgid = (xcd < r ? xcd * (q + 1) : r * (q + 1) + (xcd - r) * q) + off; }
        const int nig = WGM * nN, gid = wgid / nig, fm = gid * WGM, gsz = (nM - fm) < WGM ? (nM - fm) : WGM;
        u.pm = fm + ((wgid % nig) % gsz); u.pn = (wgid % nig) / gsz; return true;
    }
    __device__ __forceinline__ void a_ready(const Unit&) const {}
    __device__ __forceinline__ void done(const Unit&) const {}
};
__device__ __forceinline__ unsigned cvt_pk_bf16(float lo, float hi) { unsigned r; asm volatile("v_cvt_pk_bf16_f32 %0, %1, %2" : "=v"(r) : "v"(lo), "v"(hi)); return r; }
typedef float f32x2 __attribute__((ext_vector_type(2)));
struct OrderX {
    StaticOrder b; int skip;
    __device__ void init(int ntm, int N, int G_, int c_, int skip_) { b.init(ntm * BM, N, G_, c_); skip = skip_; }
    __device__ bool next(int i, Unit& u) const { if (!b.next(i, u)) return false; if (skip) u.pm = u.pm + 1 + (u.pm >> 6); return true; }
    __device__ __forceinline__ void a_ready(const Unit&) const {}
    __device__ __forceinline__ void done(const Unit&) const {}
};
struct EpiInProj {
    static constexpr bool PERM = true, AFTER_DRAIN = false;
    bf16_t* U; float* DT;
    __device__ __forceinline__ void operator()(const f32x4 (&acc)[2][2][4][2], const Unit& u, int wr, int wc, int fr, int fq) const {
        const int row0 = u.pm * BM + wr * 64 + fr;
        if (u.pn < 8) {
            const int col0 = u.pn * BM + wc * 32 + 8 * fq;
#pragma unroll
            for (int ai = 0; ai < 2; ++ai)
#pragma unroll
                for (int m = 0; m < 4; ++m) { bf16_t* rowp = U + (size_t)(row0 + ai * HALF + m * 16) * 2048 + col0;
#pragma unroll
                    for (int bj = 0; bj < 2; ++bj) { const f32x4 v0 = acc[ai][bj][m][0], v1 = acc[ai][bj][m][1];
                        u32x4 w; w.x = cvt_pk_bf16(v0[0], v0[1]); w.y = cvt_pk_bf16(v0[2], v0[3]); w.z = cvt_pk_bf16(v1[0], v1[1]); w.w = cvt_pk_bf16(v1[2], v1[3]);
                        *(u32x4*)(rowp + bj * HALF) = w; } }
        } else if (wc == 0 && fq == 0) {
#pragma unroll
            for (int ai = 0; ai < 2; ++ai)
#pragma unroll
                for (int m = 0; m < 4; ++m) { float* p = DT + (size_t)(row0 + ai * HALF + m * 16) * 8;
                    *(f32x4*)p = acc[ai][0][m][0]; *(f32x4*)(p + 4) = acc[ai][0][m][1]; }
        }
    }
};
__device__ __forceinline__ f32x4 ld4(const float* p) { return *(const f32x4*)p; }
__device__ __forceinline__ f32x4 ld4(const bf16_t* p) { const unsigned long long r = *(const unsigned long long*)p; const unsigned lo = (unsigned)r, hi = (unsigned)(r >> 32);
    return (f32x4){__uint_as_float(lo << 16), __uint_as_float(lo & 0xffff0000u), __uint_as_float(hi << 16), __uint_as_float(hi & 0xffff0000u)}; }
__device__ __forceinline__ void st4(float* p, f32x4 v) { *(f32x4*)p = v; }
__device__ __forceinline__ void st4(bf16_t* p, f32x4 v) { const unsigned long long w = (unsigned long long)cvt_pk_bf16(v[0], v[1]) | ((unsigned long long)cvt_pk_bf16(v[2], v[3]) << 32); *(unsigned long long*)p = w; }
__device__ __forceinline__ void ld8(const float* p, f32x4& a, f32x4& b) { a = *(const f32x4*)p; b = *(const f32x4*)(p + 4); }
__device__ __forceinline__ void ld8(const bf16_t* p, f32x4& a, f32x4& b) { const u32x4 r = *(const u32x4*)p;
    a = (f32x4){__uint_as_float(r.x << 16), __uint_as_float(r.x & 0xffff0000u), __uint_as_float(r.y << 16), __uint_as_float(r.y & 0xffff0000u)};
    b = (f32x4){__uint_as_float(r.z << 16), __uint_as_float(r.z & 0xffff0000u), __uint_as_float(r.w << 16), __uint_as_float(r.w & 0xffff0000u)}; }
__device__ __forceinline__ void st8(float* p, f32x4 a, f32x4 b) { *(f32x4*)p = a; *(f32x4*)(p + 4) = b; }
__device__ __forceinline__ void st8(bf16_t* p, f32x4 a, f32x4 b) { u32x4 w; w.x = cvt_pk_bf16(a[0], a[1]); w.y = cvt_pk_bf16(a[2], a[3]); w.z = cvt_pk_bf16(b[0], b[1]); w.w = cvt_pk_bf16(b[2], b[3]); *(u32x4*)p = w; }
template <class RT, class OT> struct EpiResid {
    static constexpr bool PERM = true, AFTER_DRAIN = false;
    const RT* res_lat; const RT* res_ctx; OT* out_lat; OT* out_ctx; const float* gate;
    __device__ __forceinline__ void operator()(const f32x4 (&acc)[2][2][4][2], const Unit& u, int wr, int wc, int fr, int fq) const {
        const int b = u.pm / 65, w = u.pm % 65;
        const RT* rb; OT* ob; const float* gp;
        if (w == 0) { rb = res_ctx + (size_t)b * 256 * 1024; ob = out_ctx + (size_t)b * 256 * 1024; gp = gate + 2 * 6144; }
        else { const size_t o = ((size_t)b * 16384 + (size_t)(w - 1) * 256) * 1024; rb = res_lat + o; ob = out_lat + o; gp = gate + b * 6144; }
        const int col0 = u.pn * BM + wc * 32 + 8 * fq;
        f32x4 gv[2][2];
#pragma unroll
        for (int bj = 0; bj < 2; ++bj)
#pragma unroll
            for (int n = 0; n < 2; ++n) gv[bj][n] = *(const f32x4*)(gp + col0 + bj * HALF + 4 * n);
#pragma unroll
        for (int ai = 0; ai < 2; ++ai)
#pragma unroll
            for (int m = 0; m < 4; ++m) { const size_t ro = (size_t)(wr * 64 + fr + ai * HALF + m * 16) * 1024 + col0;
#pragma unroll
                for (int bj = 0; bj < 2; ++bj) {
                    f32x4 r0, r1; ld8(rb + ro + bj * HALF, r0, r1);
                    st8(ob + ro + bj * HALF, r0 + gv[bj][0] * acc[ai][bj][m][0], r1 + gv[bj][1] * acc[ai][bj][m][1]); } }
    }
};
struct EpiSwiGLU {
    static constexpr bool PERM = true, AFTER_DRAIN = false;
    bf16_t* ACT;
    __device__ __forceinline__ static float sw(float g, float u) { return g * u * __builtin_amdgcn_rcpf(1.0f + __builtin_amdgcn_exp2f(-1.4426950408889634f * g)); }
    __device__ __forceinline__ void operator()(const f32x4 (&acc)[2][2][4][2], const Unit& u, int wr, int wc, int fr, int fq) const {
        const int row0 = u.pm * BM + wr * 64 + fr, col0 = u.pn * HALF + wc * 32 + 8 * fq;
#pragma unroll
        for (int ai = 0; ai < 2; ++ai)
#pragma unroll
            for (int m = 0; m < 4; ++m) { const f32x4 g0 = acc[ai][0][m][0], g1 = acc[ai][0][m][1], u0 = acc[ai][1][m][0], u1 = acc[ai][1][m][1];
                u32x4 w; w.x = cvt_pk_bf16(sw(g0[0], u0[0]), sw(g0[1], u0[1])); w.y = cvt_pk_bf16(sw(g0[2], u0[2]), sw(g0[3], u0[3]));
                w.z = cvt_pk_bf16(sw(g1[0], u1[0]), sw(g1[1], u1[1])); w.w = cvt_pk_bf16(sw(g1[2], u1[2]), sw(g1[3], u1[3]));
                *(u32x4*)(ACT + (size_t)(row0 + ai * HALF + m * 16) * 2816 + col0) = w; }
    }
};
template <class Epi, class Sched, bool ALIGN_EPI = false, bool SP2 = false>
__device__ __forceinline__ void gemm_phase(PG8_LAS unsigned char* lds, const Gemm g, const Sched& S, const Epi& E, const int tid) {
    const int wid = __builtin_amdgcn_readfirstlane(tid >> 6), lane = tid & 63, wr = wid >> 2, wc = wid & 3, fr = lane & 15, fq = lane >> 4;
    const int K = g.K, nt = K / BK;
    unsigned voffA[2], voffB[2];
#pragma unroll
    for (int i = 0; i < 2; ++i) { int R, C; stage_rc(tid * 16 + i * 8192, R, C); const int Rb = Epi::PERM ? ((R & ~31) + perm32(R & 31)) : R;
        voffA[i] = (unsigned)(R * K + C) * 2u; voffB[i] = (unsigned)(Rb * K + C) * 2u; }
    const size_t kstep = (size_t)(BK * 2);
    const size_t hstep = (size_t)HALF * K * 2;
    const size_t tstep = 2 * hstep;
    const unsigned ldsw = (unsigned)wid * 1024u;
    const int aoff = lds_byte(wr * 64 + fr, fq * 8), boff = lds_byte(wc * 32 + fr, fq * 8);
#define PG8_SA(b, h) (((b) * 2 + (h)) * HTB)
#define PG8_SB(b, h) ((4 + (b) * 2 + (h)) * HTB)
#define PG8_STAGE(bufoff, gbase, voff) do { _Pragma("unroll") for (int _i = 0; _i < 2; ++_i) \
        __builtin_amdgcn_global_load_lds((const unsigned*)((const char*)(gbase) + (voff)[_i]), (PG8_LAS unsigned*)(lds + (bufoff) + ldsw + _i * 8192), 16, 0, 0); } while (0)
#define PG8_LDA(dst, b, h) do { _Pragma("unroll") for (int m = 0; m < 4; ++m) _Pragma("unroll") for (int k = 0; k < 2; ++k) dst[m][k] = *(const PG8_LAS bf16x8*)(lds + PG8_SA(b, h) + aoff + m * 2048 + k * 1024); } while (0)
#define PG8_LDB(dst, b, h) do { _Pragma("unroll") for (int n = 0; n < 2; ++n) _Pragma("unroll") for (int k = 0; k < 2; ++k) dst[n][k] = *(const PG8_LAS bf16x8*)(lds + PG8_SB(b, h) + boff + n * 2048 + k * 1024); } while (0)
#define PG8_MMA(ai, bj, At, Bt) do { __builtin_amdgcn_s_setprio(1); _Pragma("unroll") for (int m = 0; m < 4; ++m) _Pragma("unroll") for (int n = 0; n < 2; ++n) _Pragma("unroll") for (int k = 0; k < 2; ++k) \
        acc[ai][bj][m][n] = __builtin_amdgcn_mfma_f32_16x16x32_bf16(Bt[n][k], At[m][k], acc[ai][bj][m][n], 0, 0, 0); __builtin_amdgcn_s_setprio(0); } while (0)
#define PG8_WAIT_V(n) asm volatile("s_waitcnt vmcnt(" #n ")" ::: "memory")
#define PG8_WAIT_L(n) asm volatile("s_waitcnt lgkmcnt(" #n ")" ::: "memory")
#define PG8_BAR __builtin_amdgcn_s_barrier()
#define PG8_SCHED __builtin_amdgcn_sched_barrier(0)
    Unit cur, nxt; int ui = 0;
    if (!S.next(0, cur)) return;
    f32x4 acc[2][2][4][2];
#pragma unroll
    for (int a = 0; a < 2; ++a)
#pragma unroll
        for (int b = 0; b < 2; ++b)
#pragma unroll
            for (int m = 0; m < 4; ++m)
#pragma unroll
                for (int n = 0; n < 2; ++n) acc[a][b][m][n] = (f32x4){0.f, 0.f, 0.f, 0.f};
    bf16x8 At[4][2], B0[2][2], B1[2][2];
    const char* cA = (const char*)g.A + (size_t)cur.pm * tstep; const char* cB = (const char*)g.Bt + (size_t)cur.pn * tstep;
    S.a_ready(cur);
    if constexpr (SP2) {
        PG8_STAGE(PG8_SB(0, 0), cB, voffB); PG8_STAGE(PG8_SB(0, 1), cB + hstep, voffB); PG8_STAGE(PG8_SA(0, 0), cA, voffA); PG8_STAGE(PG8_SA(0, 1), cA + hstep, voffA);
        if (wr == 1) PG8_BAR;
        PG8_WAIT_V(2); PG8_BAR;
        PG8_STAGE(PG8_SB(1, 0), cB + kstep, voffB); PG8_STAGE(PG8_SA(1, 0), cA + kstep, voffA); PG8_STAGE(PG8_SB(1, 1), cB + hstep + kstep, voffB);
        PG8_WAIT_V(6); PG8_BAR;
    } else {
        PG8_STAGE(PG8_SB(0, 0), cB, voffB); PG8_STAGE(PG8_SA(0, 0), cA, voffA); PG8_STAGE(PG8_SB(0, 1), cB + hstep, voffB); PG8_STAGE(PG8_SA(0, 1), cA + hstep, voffA);
        if (wr == 1) PG8_BAR;
        PG8_WAIT_V(4); PG8_BAR;
        PG8_STAGE(PG8_SB(1, 0), cB + kstep, voffB); PG8_STAGE(PG8_SA(1, 0), cA + kstep, voffA); PG8_STAGE(PG8_SB(1, 1), cB + hstep + kstep, voffB);
        PG8_WAIT_V(6); PG8_BAR;
    }
    for (;;) {
        const bool has_next = S.next(ui + 1, nxt);
        const char* nA = has_next ? (const char*)g.A + (size_t)nxt.pm * tstep : cA; const char* nB = has_next ? (const char*)g.Bt + (size_t)nxt.pn * tstep : cB;
        for (int t = 0; t < nt; t += 2) {
            const bool last = (t == nt - 2);
            const char* a1 = cA + (size_t)(t + 1) * kstep;
            const char* a2 = last ? nA : cA + (size_t)(t + 2) * kstep; const char* b2 = last ? nB : cB + (size_t)(t + 2) * kstep;
            const char* a3 = a2 + kstep; const char* b3 = b2 + kstep;
            if (last && has_next) S.a_ready(nxt);
            if constexpr (SP2) {
            PG8_LDB(B0, 0, 0); PG8_LDB(B1, 0, 1); PG8_SCHED; PG8_LDA(At, 0, 0); PG8_STAGE(PG8_SA(1, 1), a1 + hstep, voffA);
            PG8_WAIT_V(8); PG8_WAIT_L(0); PG8_BAR; PG8_MMA(0, 0, At, B0); PG8_MMA(0, 1, At, B1); PG8_BAR; PG8_SCHED;
            PG8_LDA(At, 0, 1); PG8_STAGE(PG8_SB(0, 0), b2, voffB); PG8_STAGE(PG8_SB(0, 1), b2 + hstep, voffB); PG8_STAGE(PG8_SA(0, 0), a2, voffA);
            PG8_WAIT_V(8); PG8_WAIT_L(0); PG8_BAR; PG8_MMA(1, 0, At, B0); PG8_MMA(1, 1, At, B1); PG8_BAR; PG8_SCHED;
            PG8_LDB(B0, 1, 0); PG8_LDB(B1, 1, 1); PG8_SCHED; PG8_LDA(At, 1, 0); PG8_STAGE(PG8_SA(0, 1), a2 + hstep, voffA);
            PG8_WAIT_V(8); PG8_WAIT_L(0); PG8_BAR; PG8_MMA(0, 0, At, B0); PG8_MMA(0, 1, At, B1); PG8_BAR; PG8_SCHED;
            PG8_LDA(At, 1, 1); PG8_STAGE(PG8_SB(1, 0), b3, voffB); PG8_STAGE(PG8_SB(1, 1), b3 + hstep, voffB); PG8_STAGE(PG8_SA(1, 0), a3, voffA);
            PG8_WAIT_V(8); PG8_WAIT_L(0); PG8_BAR; PG8_MMA(1, 0, At, B0); PG8_MMA(1, 1, At, B1); PG8_BAR; PG8_SCHED;
            } else {
            PG8_LDB(B0, 0, 0); PG8_SCHED; PG8_LDA(At, 0, 0); PG8_STAGE(PG8_SA(1, 1), a1 + hstep, voffA);
            PG8_WAIT_L(8); PG8_BAR; PG8_WAIT_L(0); PG8_MMA(0, 0, At, B0); PG8_BAR; PG8_SCHED;
            PG8_LDB(B1, 0, 1); PG8_STAGE(PG8_SB(0, 0), b2, voffB);
            PG8_BAR; PG8_WAIT_L(0); PG8_MMA(0, 1, At, B1); PG8_BAR;
            PG8_LDA(At, 0, 1); PG8_STAGE(PG8_SA(0, 0), a2, voffA);
            PG8_BAR; PG8_WAIT_L(0); PG8_MMA(1, 0, At, B0); PG8_BAR; PG8_SCHED;
            PG8_STAGE(PG8_SB(0, 1), b2 + hstep, voffB);
            PG8_WAIT_V(6); PG8_BAR; PG8_MMA(1, 1, At, B1); PG8_BAR;
            PG8_LDB(B0, 1, 0); PG8_SCHED; PG8_LDA(At, 1, 0); PG8_STAGE(PG8_SA(0, 1), a2 + hstep, voffA);
            PG8_WAIT_L(8); PG8_BAR; PG8_WAIT_L(0); PG8_MMA(0, 0, At, B0); PG8_BAR; PG8_SCHED;
            PG8_LDB(B1, 1, 1); PG8_STAGE(PG8_SB(1, 0), b3, voffB);
            PG8_BAR; PG8_WAIT_L(0); PG8_MMA(0, 1, At, B1); PG8_BAR;
            PG8_LDA(At, 1, 1); PG8_STAGE(PG8_SA(1, 0), a3, voffA);
            PG8_BAR; PG8_WAIT_L(0); PG8_MMA(1, 0, At, B0); PG8_BAR; PG8_SCHED;
            PG8_STAGE(PG8_SB(1, 1), b3 + hstep, voffB);
            PG8_WAIT_V(6); PG8_BAR; PG8_MMA(1, 1, At, B1); PG8_BAR;
            }
        }
        if constexpr (ALIGN_EPI) { if (wr == 0) PG8_BAR; }
        if constexpr (!Epi::AFTER_DRAIN) { E(acc, cur, wr, wc, fr, fq); S.done(cur); }
        if (!has_next) break;
#pragma unroll
        for (int a = 0; a < 2; ++a)
#pragma unroll
            for (int b = 0; b < 2; ++b)
#pragma unroll
                for (int m = 0; m < 4; ++m)
#pragma unroll
                    for (int n = 0; n < 2; ++n) acc[a][b][m][n] = (f32x4){0.f, 0.f, 0.f, 0.f};
        cur = nxt; cA = nA; cB = nB; ++ui;
        if constexpr (ALIGN_EPI) { if (wr == 1) PG8_BAR; }
    }
    PG8_WAIT_V(0);
    if constexpr (!ALIGN_EPI) { if (wr == 0) PG8_BAR; }
    PG8_BAR;
    if constexpr (Epi::AFTER_DRAIN) { E.fused(acc, cur, wr, wc, fr, fq, lds, wid, lane); S.done(cur); }
#undef PG8_SA
#undef PG8_SB
#undef PG8_STAGE
#undef PG8_LDA
#undef PG8_LDB
#undef PG8_MMA
#undef PG8_WAIT_V
#undef PG8_WAIT_L
#undef PG8_BAR
#undef PG8_SCHED
}
}
namespace att {
using bf16 = __hip_bfloat16;
constexpr int   D = 128, NW = 8, QBLK = 32, KVBLK = 64;
constexpr float SCALE = 0.088388347648318440f;
constexpr float THR = 8.f;
constexpr int SDEPTH = 2;
constexpr int LDQ = 2048, LDK = 2048, LDO = 1024;
constexpr size_t SHM_V = KVBLK * D * 2, SHM_K = KVBLK * D * 2, SHM_ATTN = 2 * SHM_V + 2 * SHM_K + NW * 64 * 4;
using bf16x8 = __attribute__((ext_vector_type(8))) short;
using s16x4  = __attribute__((ext_vector_type(4))) short;
using f32x16 = __attribute__((ext_vector_type(16))) float;
using f32x8  = __attribute__((ext_vector_type(8))) float;
using u32x4  = __attribute__((ext_vector_type(4))) unsigned;
#define KSWZ(row, colB) ((row) * 256 + ((colB) ^ (((row) & 7) << 4)))
#define SBAR() __builtin_amdgcn_sched_barrier(0)
__device__ __forceinline__ int crow(int r, int hi) { return (r & 3) + 8 * (r >> 2) + 4 * hi; }
__device__ __forceinline__ unsigned cvtpk(float lo, float hi) {
  unsigned r; asm volatile("v_cvt_pk_bf16_f32 %0, %1, %2" : "=v"(r) : "v"(lo), "v"(hi)); return r;
}
template <typename TIn> struct Stage;
template <> struct Stage<bf16>  { using T = bf16x8;
  __device__ static __forceinline__ T ld8(const bf16* p) { return *reinterpret_cast<const bf16x8*>(p); }
  __device__ static __forceinline__ bf16x8 tobf(T x) { return x; } };
template <> struct Stage<float> { using T = f32x8;
  __device__ static __forceinline__ T ld8(const float* p) { return *reinterpret_cast<const f32x8*>(p); }
  __device__ static __forceinline__ bf16x8 tobf(T x) {
    u32x4 w = {cvtpk(x[0], x[1]), cvtpk(x[2], x[3]), cvtpk(x[4], x[5]), cvtpk(x[6], x[7])}; return *reinterpret_cast<bf16x8*>(&w); } };

template <bool FIXED>
__device__ __forceinline__ void partialSM(f32x16& p0, f32x16& p1, float& m_reg, float& mn, float& alpha) {
  if constexpr (FIXED) { mn = 0.f; alpha = 1.f; }
  else {
    float pmax = p0[0]; for (int r = 1; r < 16; ++r) pmax = fmaxf(pmax, p0[r]); for (int r = 0; r < 16; ++r) pmax = fmaxf(pmax, p1[r]);
    { auto rr = __builtin_amdgcn_permlane32_swap(__float_as_uint(pmax), __float_as_uint(pmax), false, false);
      pmax = fmaxf(__uint_as_float(rr[0]), __uint_as_float(rr[1])); }
    if (__builtin_expect(__all(pmax - m_reg <= THR), 1)) { mn = m_reg; alpha = 1.f; }
    else { mn = fmaxf(m_reg, pmax); alpha = __builtin_amdgcn_exp2f(m_reg - mn); m_reg = mn; }
    for (int r = 0; r < 16; ++r) p0[r] -= mn; for (int r = 0; r < 16; ++r) p1[r] -= mn;
  }
  for (int r = 0; r < 16; ++r) p0[r] = __builtin_amdgcn_exp2f(p0[r]);
}
__device__ __forceinline__ void finishSM(f32x16& p0, f32x16& p1, float alpha, float& l_reg, bf16x8& pa0, bf16x8& pa1, bf16x8& pa2, bf16x8& pa3) {
  for (int r = 0; r < 16; ++r) p1[r] = __builtin_amdgcn_exp2f(p1[r]);
  float ps = 0; for (int r = 0; r < 16; ++r) ps += p0[r]; for (int r = 0; r < 16; ++r) ps += p1[r];
  asm volatile("" : "+v"(ps));
  l_reg = l_reg * alpha + ps;
#define PK4(P, BASE, OUT) do { u32x4 w = {cvtpk(P[BASE + 0], P[BASE + 1]), cvtpk(P[BASE + 2], P[BASE + 3]), cvtpk(P[BASE + 4], P[BASE + 5]), cvtpk(P[BASE + 6], P[BASE + 7])}; \
    OUT = *reinterpret_cast<bf16x8*>(&w); } while (0)
  PK4(p0, 0, pa0); PK4(p0, 8, pa1); PK4(p1, 0, pa2); PK4(p1, 8, pa3);
#undef PK4
}
__device__ __forceinline__ void qkt(f32x16& p0, f32x16& p1, const bf16* Ks, const bf16x8* qr, int r32, int hi) {
  p0 = f32x16{}; p1 = f32x16{};
  for (int d0 = 0; d0 < 8; ++d0) { int cb = (d0 * 16 + hi * 8) * 2;
    bf16x8 b0 = *reinterpret_cast<const bf16x8*>((const char*)Ks + KSWZ(r32, cb));
    bf16x8 b1 = *reinterpret_cast<const bf16x8*>((const char*)Ks + KSWZ(32 + r32, cb));
    p0 = __builtin_amdgcn_mfma_f32_32x32x16_bf16(b0, qr[d0], p0, 0, 0, 0);
    p1 = __builtin_amdgcn_mfma_f32_32x32x16_bf16(b1, qr[d0], p1, 0, 0, 0); }
}
__device__ __forceinline__ int v_st(int k, int c) { const int kk = k;
  return ((kk >> 3) * 4 + (c >> 5)) * 512 + ((kk & 7) * 32 + (c & 31)) * 2; }
__device__ __forceinline__ int v_rd_base(int lane) { return ((lane & 3) << 3) | (((lane >> 2) & 3) << 6) | (((lane >> 4) & 1) << 5) | (((lane >> 5) & 1) << 8); }
constexpr int v_rd_off(int d0, int ks, int half) { return d0 * 512 + ks * 4096 + half * 2048; }
template <int OFF> __device__ __forceinline__ s16x4 tr_read(int vb) {
  s16x4 r; asm volatile("ds_read_b64_tr_b16 %0, %1 offset:%2" : "=&v"(r) : "v"(vb), "i"(OFF) : "memory"); return r;
}
template <int D0> __device__ __forceinline__ void pv_one(f32x16& od, int vb, bf16x8 pa0, bf16x8 pa1, bf16x8 pa2, bf16x8 pa3) {
  const s16x4 l0 = tr_read<v_rd_off(D0, 0, 0)>(vb), h0 = tr_read<v_rd_off(D0, 0, 1)>(vb), l1 = tr_read<v_rd_off(D0, 1, 0)>(vb), h1 = tr_read<v_rd_off(D0, 1, 1)>(vb);
  const s16x4 l2 = tr_read<v_rd_off(D0, 2, 0)>(vb), h2 = tr_read<v_rd_off(D0, 2, 1)>(vb), l3 = tr_read<v_rd_off(D0, 3, 0)>(vb), h3 = tr_read<v_rd_off(D0, 3, 1)>(vb);
  asm volatile("s_waitcnt lgkmcnt(0)" ::: "memory"); SBAR();
#define PK(L, H) (bf16x8){L[0], L[1], L[2], L[3], H[0], H[1], H[2], H[3]}
  od = __builtin_amdgcn_mfma_f32_32x32x16_bf16(pa0, PK(l0, h0), od, 0, 0, 0);
  od = __builtin_amdgcn_mfma_f32_32x32x16_bf16(pa1, PK(l1, h1), od, 0, 0, 0);
  od = __builtin_amdgcn_mfma_f32_32x32x16_bf16(pa2, PK(l2, h2), od, 0, 0, 0);
  od = __builtin_amdgcn_mfma_f32_32x32x16_bf16(pa3, PK(l3, h3), od, 0, 0, 0);
#undef PK
}
__device__ __forceinline__ void pv_d0(f32x16* o, int vb, bf16x8 pa0, bf16x8 pa1, bf16x8 pa2, bf16x8 pa3) {
  pv_one<0>(o[0], vb, pa0, pa1, pa2, pa3); pv_one<1>(o[1], vb, pa0, pa1, pa2, pa3); pv_one<2>(o[2], vb, pa0, pa1, pa2, pa3); pv_one<3>(o[3], vb, pa0, pa1, pa2, pa3);
}

__device__ __forceinline__ void load_q_normed(const bf16* Qw, const float* qnw, const float2* rope, int trow, int hi, bf16x8* qr) {
  constexpr float C = SCALE * 1.4426950408889634f;
  float v[8][8]; float ss = 0.f;
#pragma unroll
  for (int d0 = 0; d0 < 8; ++d0) { const u32x4 raw = *reinterpret_cast<const u32x4*>(Qw + d0 * 16);
    v[d0][0] = __uint_as_float(raw.x << 16); v[d0][1] = __uint_as_float(raw.x & 0xffff0000u); v[d0][2] = __uint_as_float(raw.y << 16); v[d0][3] = __uint_as_float(raw.y & 0xffff0000u);
    v[d0][4] = __uint_as_float(raw.z << 16); v[d0][5] = __uint_as_float(raw.z & 0xffff0000u); v[d0][6] = __uint_as_float(raw.w << 16); v[d0][7] = __uint_as_float(raw.w & 0xffff0000u);
#pragma unroll
    for (int j = 0; j < 8; ++j) ss += v[d0][j] * v[d0][j]; }
  { auto rr = __builtin_amdgcn_permlane32_swap(__float_as_uint(ss), __float_as_uint(ss), false, false); ss = __uint_as_float(rr[0]) + __uint_as_float(rr[1]); }
  const float rstd = rsqrtf(ss * (1.0f / 128.0f) + 1e-6f);
#pragma unroll
  for (int d0 = 0; d0 < 8; ++d0) { const float* wp = qnw + d0 * 16 + hi * 8;
#pragma unroll
    for (int j = 0; j < 8; ++j) v[d0][j] = (v[d0][j] * rstd) * (wp[j] * C); }
  if (trow >= 0) {
#pragma unroll
    for (int ax = 0; ax < 2; ++ax) { const float2* rp = rope + (ax ? (trow & 63) : (trow >> 6)) * 32 + hi * 8;
#pragma unroll
      for (int b = 0; b < 2; ++b)
#pragma unroll
        for (int j = 0; j < 8; ++j) { const float2 cs = rp[16 * b + j]; const float x1 = v[4 * ax + b][j], x2 = v[4 * ax + b + 2][j];
          v[4 * ax + b][j] = x1 * cs.x - x2 * cs.y; v[4 * ax + b + 2][j] = x2 * cs.x + x1 * cs.y; } } }
#pragma unroll
  for (int d0 = 0; d0 < 8; ++d0) { u32x4 w = {cvtpk(v[d0][0], v[d0][1]), cvtpk(v[d0][2], v[d0][3]), cvtpk(v[d0][4], v[d0][5]), cvtpk(v[d0][6], v[d0][7])}; qr[d0] = *reinterpret_cast<bf16x8*>(&w); }
}
template <typename TQ, bool FIXED>
__device__ __forceinline__ void attn_dense_body(const TQ* __restrict__ Qb, const bf16* __restrict__ Kh, const bf16* __restrict__ Vh,
                                                bf16* __restrict__ Ob, int seq, char* lds, const int tid, const float* qnw, const float2* rope, const int t0) {
  using St = Stage<bf16>; using SQ = Stage<TQ>;
  const int wid = tid >> 6, lane = tid & 63, r32 = lane & 31, hi = lane >> 5;
  bf16* V_lds = (bf16*)lds; bf16* K_lds = (bf16*)(lds + 2 * SHM_V);
  float* ws = (float*)(lds + 2 * SHM_V + 2 * SHM_K) + wid * 64; float* li_l = ws; float* al_l = ws + 32;
  float m_reg = FIXED ? 0.f : -1e30f, l_reg = 0; f32x16 o[4] = {}; bf16x8 qr[8];
  const TQ* Qw = Qb + (long)(wid * QBLK + r32) * LDQ + hi * 8;
  load_q_normed(Qw, qnw, rope, t0 < 0 ? -1 : t0 + wid * QBLK + r32, hi, qr);
  const int sr = tid >> 4, sc = (tid & 15) * 8, vst0 = v_st(sr, sc), vst1 = v_st(32 + sr, sc);
  const int vb0 = (int)(uintptr_t)V_lds + v_rd_base(lane);
  struct { typename St::T vs0, vs1, ks0, ks1; } sr_[SDEPTH];
#define SLOAD(i, k0) do { sr_[i].vs0 = St::ld8(&Vh[(long)((k0) + sr) * LDK + sc]); sr_[i].vs1 = St::ld8(&Vh[(long)((k0) + 32 + sr) * LDK + sc]); \
    sr_[i].ks0 = St::ld8(&Kh[(long)((k0) + sr) * LDK + sc]); sr_[i].ks1 = St::ld8(&Kh[(long)((k0) + 32 + sr) * LDK + sc]); } while (0)
#define SWRITE(b, i) do { *(bf16x8*)((char*)V_lds + (b) * SHM_V + vst0) = St::tobf(sr_[i].vs0);          \
    *(bf16x8*)((char*)V_lds + (b) * SHM_V + vst1) = St::tobf(sr_[i].vs1); int kc = sc * 2;               \
    *(bf16x8*)((char*)K_lds + (b) * SHM_K + KSWZ(sr, kc)) = St::tobf(sr_[i].ks0);                       \
    *(bf16x8*)((char*)K_lds + (b) * SHM_K + KSWZ(32 + sr, kc)) = St::tobf(sr_[i].ks1); } while (0)
#define SWAIT() do { if constexpr (SDEPTH == 2) asm volatile("s_waitcnt vmcnt(4)" ::: "memory"); else asm volatile("s_waitcnt vmcnt(0)" ::: "memory"); } while (0)
#define RESC(a) do { if (__any((a) < 1.f)) { if (hi == 0) al_l[r32] = (a); asm volatile("s_waitcnt lgkmcnt(0)" ::: "memory"); \
    for (int d = 0; d < 4; ++d) for (int r = 0; r < 16; ++r) o[d][r] *= al_l[crow(r, hi)]; } } while (0)
  f32x16 pA0, pA1, pB0, pB1; float mnA, mnB, alA, alB; bf16x8 pa0, pa1, pa2, pa3; const int NT = seq / KVBLK;
  constexpr int SE = 0, SO = SDEPTH - 1;
  SLOAD(SE, 0); asm volatile("s_waitcnt vmcnt(0)" ::: "memory"); SWRITE(0, SE); __syncthreads();
  qkt(pA0, pA1, K_lds, qr, r32, hi); partialSM<FIXED>(pA0, pA1, m_reg, mnA, alA);
  SLOAD(SO, KVBLK); if constexpr (SDEPTH == 2) { if (2 < NT) SLOAD(SE, 2 * KVBLK); }
  SWAIT(); SWRITE(1, SO); __syncthreads();
  for (int j = 1; j + 1 < NT; j += 2) {
    SBAR(); qkt(pB0, pB1, (bf16*)((char*)K_lds + SHM_K), qr, r32, hi);
    finishSM(pA0, pA1, alA, l_reg, pa0, pa1, pa2, pa3); SBAR();
    SLOAD(SO, (j + SDEPTH) * KVBLK); SBAR();
    pv_d0(o, vb0, pa0, pa1, pa2, pa3); partialSM<FIXED>(pB0, pB1, m_reg, mnB, alB);
    __syncthreads(); SWAIT(); SWRITE(0, SE);
    RESC(alB); __syncthreads();
    SBAR(); qkt(pA0, pA1, K_lds, qr, r32, hi);
    finishSM(pB0, pB1, alB, l_reg, pa0, pa1, pa2, pa3); SBAR();
    if (SDEPTH == 1 || j + 3 < NT) SLOAD(SE, (j + 1 + SDEPTH) * KVBLK); SBAR();
    pv_d0(o, vb0 + (int)SHM_V, pa0, pa1, pa2, pa3); partialSM<FIXED>(pA0, pA1, m_reg, mnA, alA);
    __syncthreads(); SWAIT(); SWRITE(1, SO);
    RESC(alA); __syncthreads();
  }
  SBAR(); qkt(pB0, pB1, (bf16*)((char*)K_lds + SHM_K), qr, r32, hi);
  finishSM(pA0, pA1, alA, l_reg, pa0, pa1, pa2, pa3); SBAR();
  pv_d0(o, vb0, pa0, pa1, pa2, pa3); partialSM<FIXED>(pB0, pB1, m_reg, mnB, alB);
  __syncthreads(); RESC(alB);
  finishSM(pB0, pB1, alB, l_reg, pa0, pa1, pa2, pa3); SBAR();
  pv_d0(o, vb0 + (int)SHM_V, pa0, pa1, pa2, pa3);
  { auto rr = __builtin_amdgcn_permlane32_swap(__float_as_uint(l_reg), __float_as_uint(l_reg), false, false); l_reg = __uint_as_float(rr[0]) + __uint_as_float(rr[1]); }
  if (hi == 0) li_l[r32] = l_reg; asm volatile("s_waitcnt lgkmcnt(0)" ::: "memory");
  float rli[16];
#pragma unroll
  for (int r = 0; r < 16; ++r) rli[r] = __builtin_amdgcn_rcpf(li_l[crow(r, hi)]);
  bf16* Ow = Ob + (long)(wid * QBLK) * LDO;
#pragma unroll
  for (int r = 0; r < 16; ++r) { int orow = crow(r, hi);
    for (int d0 = 0; d0 < 4; ++d0) Ow[(long)orow * LDO + d0 * 32 + r32] = __float2bfloat16(o[d0][r] * rli[r]); }
#undef SLOAD
#undef SWRITE
#undef SWAIT
#undef RESC
}

constexpr size_t SHM_ATTN_DMA = 4 * SHM_V + 4 * SHM_K + NW * 64 * 4;
#define ATT_LAS __attribute__((address_space(3)))
template <typename TQ>
__device__ __forceinline__ void attn_dense_body_dma(const TQ* __restrict__ Qb, const bf16* __restrict__ Kh, const bf16* __restrict__ Vh,
                                                    bf16* __restrict__ Ob, int seq, char* lds, const int tid, const float* qnw, const float2* rope, const int t0) {
  using SQ = Stage<TQ>;
  const int wid = __builtin_amdgcn_readfirstlane(tid >> 6), lane = tid & 63, r32 = lane & 31, hi = lane >> 5;
  char* V_lds = lds; char* K_lds = lds + 4 * SHM_V;
  float* ws = (float*)(lds + 4 * SHM_V + 4 * SHM_K) + wid * 64; float* li_l = ws;
  float m_reg = 0.f, l_reg = 0; f32x16 o[4] = {}; bf16x8 qr[8];
  const TQ* Qw = Qb + (long)(wid * QBLK + r32) * LDQ + hi * 8;
  load_q_normed(Qw, qnw, rope, t0 < 0 ? -1 : t0 + wid * QBLK + r32, hi, qr);
  const int vb0 = (int)(uintptr_t)V_lds + v_rd_base(lane);
  int koff[2], voff[2];
#pragma unroll
  for (int i = 0; i < 2; ++i) { const int P = wid * 1024 + lane * 16 + i * 8192;
    { const int row = P >> 8, colB = (P & 255) ^ ((row & 7) << 4); koff[i] = row * LDK + (colB >> 1); }
    { const int sub = P >> 9, k = (sub >> 2) * 8 + ((lane & 31) >> 2), c = (sub & 3) * 32 + (lane & 3) * 8; voff[i] = k * LDK + c; } }
#define DMA_TILE(t, slot) do { const bf16* kb_ = Kh + (long)(t) * (KVBLK * LDK); const bf16* vb_ = Vh + (long)(t) * (KVBLK * LDK); \
    __builtin_amdgcn_global_load_lds((const unsigned*)(kb_ + koff[0]), (ATT_LAS unsigned*)(K_lds + (slot) * SHM_K + wid * 1024), 16, 0, 0); \
    __builtin_amdgcn_global_load_lds((const unsigned*)(kb_ + koff[1]), (ATT_LAS unsigned*)(K_lds + (slot) * SHM_K + 8192 + wid * 1024), 16, 0, 0); \
    __builtin_amdgcn_global_load_lds((const unsigned*)(vb_ + voff[0]), (ATT_LAS unsigned*)(V_lds + (slot) * SHM_V + wid * 1024), 16, 0, 0); \
    __builtin_amdgcn_global_load_lds((const unsigned*)(vb_ + voff[1]), (ATT_LAS unsigned*)(V_lds + (slot) * SHM_V + 8192 + wid * 1024), 16, 0, 0); } while (0)
#define PUBLISH(n) do { asm volatile("s_waitcnt vmcnt(" #n ")" ::: "memory"); asm volatile("s_waitcnt lgkmcnt(0)" ::: "memory"); __builtin_amdgcn_s_barrier(); SBAR(); } while (0)
  f32x16 pA0, pA1, pB0, pB1; float mnA, mnB, alA, alB; bf16x8 pa0, pa1, pa2, pa3; const int NT = seq / KVBLK;
  DMA_TILE(0, 0); DMA_TILE(1, 1);
  PUBLISH(4);
  qkt(pA0, pA1, (const bf16*)K_lds, qr, r32, hi); partialSM<true>(pA0, pA1, m_reg, mnA, alA);
  DMA_TILE(2, 2);
  PUBLISH(4);
  for (int j = 1; j + 1 < NT; j += 2) {
    SBAR(); qkt(pB0, pB1, (const bf16*)(K_lds + (j & 3) * (int)SHM_K), qr, r32, hi);
    finishSM(pA0, pA1, alA, l_reg, pa0, pa1, pa2, pa3); SBAR();
    DMA_TILE(j + 2, (j + 2) & 3); SBAR();
    pv_d0(o, vb0 + ((j - 1) & 3) * (int)SHM_V, pa0, pa1, pa2, pa3); partialSM<true>(pB0, pB1, m_reg, mnB, alB);
    PUBLISH(4);
    SBAR(); qkt(pA0, pA1, (const bf16*)(K_lds + ((j + 1) & 3) * (int)SHM_K), qr, r32, hi);
    finishSM(pB0, pB1, alB, l_reg, pa0, pa1, pa2, pa3); SBAR();
    if (j + 3 < NT) { DMA_TILE(j + 3, (j + 3) & 3); } SBAR();
    pv_d0(o, vb0 + (j & 3) * (int)SHM_V, pa0, pa1, pa2, pa3); partialSM<true>(pA0, pA1, m_reg, mnA, alA);
    if (j + 3 < NT) { PUBLISH(4); } else { PUBLISH(0); }
  }
  SBAR(); qkt(pB0, pB1, (const bf16*)(K_lds + ((NT - 1) & 3) * (int)SHM_K), qr, r32, hi);
  finishSM(pA0, pA1, alA, l_reg, pa0, pa1, pa2, pa3); SBAR();
  pv_d0(o, vb0 + ((NT - 2) & 3) * (int)SHM_V, pa0, pa1, pa2, pa3); partialSM<true>(pB0, pB1, m_reg, mnB, alB);
  finishSM(pB0, pB1, alB, l_reg, pa0, pa1, pa2, pa3); SBAR();
  pv_d0(o, vb0 + ((NT - 1) & 3) * (int)SHM_V, pa0, pa1, pa2, pa3);
  { auto rr = __builtin_amdgcn_permlane32_swap(__float_as_uint(l_reg), __float_as_uint(l_reg), false, false); l_reg = __uint_as_float(rr[0]) + __uint_as_float(rr[1]); }
  if (hi == 0) li_l[r32] = l_reg; asm volatile("s_waitcnt lgkmcnt(0)" ::: "memory");
  float rli[16];
#pragma unroll
  for (int r = 0; r < 16; ++r) rli[r] = __builtin_amdgcn_rcpf(li_l[crow(r, hi)]);
  bf16* Ow = Ob + (long)(wid * QBLK) * LDO;
#pragma unroll
  for (int r = 0; r < 16; ++r) { int orow = crow(r, hi);
    for (int d0 = 0; d0 < 4; ++d0) Ow[(long)orow * LDO + d0 * 32 + r32] = __float2bfloat16(o[d0][r] * rli[r]); }
  asm volatile("s_waitcnt vmcnt(0)" ::: "memory");
#undef DMA_TILE
#undef PUBLISH
}
}
constexpr int DM = 1024, LSEQ = 16384, CTXL = 256, NBATCH = 2, SEQU = LSEQ + CTXL, MROWS = NBATCH * SEQU;
constexpr int NU = 2048;
constexpr int NIN = 2304;
constexpr int DFF = 2816, NMODV = 6144;
constexpr int NCHUNK = MROWS / 128, CPB = SEQU / 128;
constexpr float EPSN = 1e-6f;
constexpr size_t MiB = 1u << 20;
constexpr size_t WS_WIN = 0, WS_WOUT = 9 * MiB, WS_W13 = 13 * MiB, WS_W2 = 35 * MiB, WS_MODP = 46 * MiB, WS_MOD = 48 * MiB, WS_ROPE = 49 * MiB, WS_DT = 50 * MiB, WS_CD = 52 * MiB;
constexpr size_t WS_BAR = 52 * MiB + 512 * 1024;
constexpr size_t WS_ST = 53 * MiB, WS_SP = 86 * MiB, WS_XBC = 103 * MiB, WS_HN = 53 * MiB  ;
constexpr size_t WS_XSL = 136 * MiB, WS_XSC = 264 * MiB, WS_U = 266 * MiB, WS_MIX = 396 * MiB, WS_ACT = 266 * MiB  , WS_END = 461 * MiB;
constexpr int LDS_TAB = 149504, LDS_BYTES = 149504 + 512;
constexpr int NPHASE = 20;

typedef unsigned short bf16u;
typedef short bf16x8 __attribute__((ext_vector_type(8)));
typedef short s16x4 __attribute__((ext_vector_type(4)));
typedef float f32x4 __attribute__((ext_vector_type(4)));
typedef unsigned u32x4 __attribute__((ext_vector_type(4)));
typedef unsigned u32x2 __attribute__((ext_vector_type(2)));
#define LDSW() asm volatile("s_waitcnt lgkmcnt(0)" ::: "memory")
__device__ __forceinline__ float bf2f(unsigned short h) { return __uint_as_float((unsigned)h << 16); }
__device__ __forceinline__ float bflo(unsigned w) { return __uint_as_float(w << 16); }
__device__ __forceinline__ float bfhi(unsigned w) { return __uint_as_float(w & 0xffff0000u); }
__device__ __forceinline__ unsigned pk2(float lo, float hi) { return pg8::cvt_pk_bf16(lo, hi); }
__device__ __forceinline__ unsigned short f2bf1(float f) { return (unsigned short)(pg8::cvt_pk_bf16(f, 0.f) & 0xffffu); }
__device__ __forceinline__ float bperm(float v, int srclane) { return __builtin_bit_cast(float, __builtin_amdgcn_ds_bpermute(srclane << 2, __builtin_bit_cast(int, v))); }
__device__ __forceinline__ float rdlane(float v, int l) { return __builtin_bit_cast(float, __builtin_amdgcn_readlane(__builtin_bit_cast(int, v), l)); }
__device__ __forceinline__ float wave_sum(float v, int lane) {
#pragma unroll
    for (int o = 1; o < 64; o <<= 1) v += bperm(v, lane ^ o);
    return v;
}
__device__ __forceinline__ float siluf(float x) { return x * __builtin_amdgcn_rcpf(1.0f + __builtin_amdgcn_exp2f(-1.4426950408889634f * x)); }
__device__ __forceinline__ float softplusf(float x) { return fmaxf(x, 0.f) + log1pf(__expf(-fabsf(x))); }

struct Params {
    const float *x, *c, *ctx, *c_ctx, *norm1_w, *norm2_w, *w_mod, *b_mod, *w_in, *pool_w, *pool_scale, *conv_w, *conv_b, *dt_bias, *a_log, *d_skip, *ssd_norm_w,
                *q_norm_w, *k_norm_w, *w_out, *w1, *w3, *w2;
    float* out; unsigned char* ws; int ph_lo, ph_hi;
};

__device__ __forceinline__ void transpose_tile(const float* W, int ldw, int scol0, bf16u* WT, int K, int n0, int k0, float* scr, int lane) {
    const int nn = lane & 31; const int sc = scol0 >= 0 ? scol0 + nn : ((scol0 == -2 && nn < 8) ? 1024 + nn : -1);
#pragma unroll 8
    for (int i = 0; i < 32; ++i) { const int kk = 2 * i + (lane >> 5); scr[kk * 33 + nn] = sc >= 0 ? W[(size_t)(k0 + kk) * ldw + sc] : 0.f; }
    LDSW();
    const int c = lane & 7;
#pragma unroll
    for (int j = 0; j < 4; ++j) { const int n = (lane >> 3) + 8 * j; const float* s = scr + (8 * c) * 33 + n;
        u32x4 o; o.x = pk2(s[0 * 33], s[1 * 33]); o.y = pk2(s[2 * 33], s[3 * 33]); o.z = pk2(s[4 * 33], s[5 * 33]); o.w = pk2(s[6 * 33], s[7 * 33]);
        *(u32x4*)(WT + (size_t)(n0 + n) * K + k0 + 8 * c) = o; }
    LDSW();
}
constexpr int PREP_I_IN = 16 * 72, PREP_I_OUT = 16 * 32, PREP_I_13 = 16 * 176, PREP_I_2 = 44 * 32, PREP_I_L = PREP_I_IN + PREP_I_OUT + PREP_I_13 + PREP_I_2;
__device__ __forceinline__ void prep_weight_item(const Params& P, int l, int r, float* scr, int lane) {
    if (r < PREP_I_IN) { const int kb = r / 72, nb = r % 72, n0 = 32 * nb; const int sc0 = n0 < 1024 ? n0 : (n0 < 2048 ? n0 + 8 : (n0 == 2048 ? -2 : -1));
        transpose_tile(P.w_in + (size_t)l * 1024 * 2056, 2056, sc0, (bf16u*)(P.ws + WS_WIN) + (size_t)l * NIN * 1024, 1024, n0, 64 * kb, scr, lane); return; }
    r -= PREP_I_IN;
    if (r < PREP_I_OUT) { const int kb = r / 32, nb = r % 32;
        transpose_tile(P.w_out + (size_t)l * 1024 * 1024, 1024, 32 * nb, (bf16u*)(P.ws + WS_WOUT) + (size_t)l * 1024 * 1024, 1024, 32 * nb, 64 * kb, scr, lane); return; }
    r -= PREP_I_OUT;
    if (r < PREP_I_13) { const int kb = r / 176, nb = r % 176, n0 = 32 * nb, pn = n0 >> 8, s = (n0 >> 7) & 1, i0 = n0 & 127;
        transpose_tile((s ? P.w3 : P.w1) + (size_t)l * 1024 * DFF, DFF, 128 * pn + i0, (bf16u*)(P.ws + WS_W13) + (size_t)l * 2 * DFF * 1024, 1024, n0, 64 * kb, scr, lane); return; }
    r -= PREP_I_13;
    { const int kb = r / 32, nb = r % 32;
        transpose_tile(P.w2 + (size_t)l * DFF * 1024, 1024, 32 * nb, (bf16u*)(P.ws + WS_W2) + (size_t)l * 1024 * DFF, DFF, 32 * nb, 64 * kb, scr, lane); }
}
__device__ __forceinline__ void prep_layer1_weights(const Params& P, unsigned char* lds, int lane, int wave, int vb, int nvb) {
    float* scr = (float*)(lds + wave * 8448);
    for (int r = vb * 8 + wave; r < PREP_I_L; r += nvb * 8) prep_weight_item(P, 1, r, scr, lane);
}
__device__ __forceinline__ void phase_prep(const Params& P, unsigned char* lds, int tid, int lane, int wave, int G, const int bid) {
    float* SC = (float*)(lds + 8 * 8448);
    for (int i = tid; i < 3072; i += 512) { const int wh = i >> 10, k = i & 1023; const float v = wh < 2 ? P.c[wh * 1024 + k] : P.c_ctx[k]; SC[i] = siluf(v); }
    __syncthreads();
    float* scr = (float*)(lds + wave * 8448);
    const int gw = bid * 8 + wave, NGW = G * 8;
    constexpr int I_IN = 16 * 72, I_OUT = 16 * 32, I_13 = 16 * 176, I_2 = 44 * 32, I_L = I_IN + I_OUT + I_13 + I_2, I_MOD = 384;
    for (int it = gw; it < I_MOD + I_L; it += NGW) {
        if (it < I_MOD) {
            const int l = it / 192, r = it % 192, cb = r >> 3, ks = r & 7;
            const float* W = P.w_mod + (size_t)l * 1024 * NMODV + (size_t)(ks * 128) * NMODV + cb * 256 + 4 * lane;
            f32x4 a0 = {0.f, 0.f, 0.f, 0.f}, a1 = a0, a2 = a0;
#pragma unroll 8
            for (int k = 0; k < 128; ++k) { const f32x4 w = *(const f32x4*)(W + (size_t)k * NMODV); const int kk = ks * 128 + k;
                a0 += SC[kk] * w; a1 += SC[1024 + kk] * w; a2 += SC[2048 + kk] * w; }
            float* MP = (float*)(P.ws + WS_MODP) + (size_t)((l * 8 + ks) * 3) * NMODV + cb * 256 + 4 * lane;
            *(f32x4*)MP = a0; *(f32x4*)(MP + NMODV) = a1; *(f32x4*)(MP + 2 * NMODV) = a2;
            continue;
        }
        prep_weight_item(P, 0, it - I_MOD, scr, lane);
    }
    for (int i = bid * 512 + tid; i < 256 * 32; i += G * 512) { const int pos = i >> 5, fi = i & 31;
        const float inv = powf(10000.0f, -(float)(2 * fi) / 64.0f); const float ang = (float)pos * inv;
        ((float2*)(P.ws + WS_ROPE))[i] = make_float2(cosf(ang), sinf(ang)); }
}
__device__ __forceinline__ void phase_modreduce(const Params& P, int tid, int G, const int bid) {
    const float* MP = (const float*)(P.ws + WS_MODP); float* MOD = (float*)(P.ws + WS_MOD);
    for (int i = bid * 512 + tid; i < 2 * 3 * NMODV; i += G * 512) { const int l = i / (3 * NMODV), r = i % (3 * NMODV), wh = r / NMODV, col = r % NMODV;
        float v = P.b_mod[l * NMODV + col];
#pragma unroll
        for (int ks = 0; ks < 8; ++ks) v += MP[(size_t)((l * 8 + ks) * 3 + wh) * NMODV + col];
        MOD[i] = v; }
}

template <class T>
__device__ __forceinline__ void phase_norm(const T* xl, const T* xc, const float* nw, const float* mod  , int sh_off, int sc_off,
                                           bf16u* HN, int skip_ctx, int lane, int wave, int G, const int bid) {
    const int gw = bid * 8 + wave, NGW = G * 8; int cur = -1; f32x4 a[4], s[4];
    for (int m = gw; m < MROWS; m += NGW) {
        const int b = m / SEQU, j = m % SEQU; const bool isc = j < CTXL; if (isc && skip_ctx) continue;
        const int wh = isc ? 2 : b; const T* src = isc ? xc + (size_t)(b * CTXL + j) * DM : xl + (size_t)(b * LSEQ + j - CTXL) * DM;
        if (wh != cur) { cur = wh;
#pragma unroll
            for (int jj = 0; jj < 4; ++jj) { const int k = 8 * lane + 4 * (jj & 1) + 512 * (jj >> 1); const f32x4 w = *(const f32x4*)(nw + k), sc = *(const f32x4*)(mod + wh * NMODV + sc_off + k);
                a[jj] = w * (sc + 1.0f); s[jj] = *(const f32x4*)(mod + wh * NMODV + sh_off + k); } }
        f32x4 v[4]; float ss = 0.f;
#pragma unroll
        for (int h = 0; h < 2; ++h) pg8::ld8(src + 8 * lane + 512 * h, v[2 * h], v[2 * h + 1]);
#pragma unroll
        for (int jj = 0; jj < 4; ++jj) ss += (v[jj].x * v[jj].x + v[jj].y * v[jj].y) + (v[jj].z * v[jj].z + v[jj].w * v[jj].w);
        const float rstd = rsqrtf(wave_sum(ss, lane) * (1.0f / DM) + EPSN);
#pragma unroll
        for (int h = 0; h < 2; ++h) pg8::st8(HN + (size_t)m * DM + 8 * lane + 512 * h, (v[2 * h] * rstd) * a[2 * h] + s[2 * h], (v[2 * h + 1] * rstd) * a[2 * h + 1] + s[2 * h + 1]);
    }
}

__device__ __forceinline__ float ssd_dt_arrays(const Params& P, int l, int row0, float* ARR_dt, float* ARR_acs, int lane, int wave) {
    const float* DT = (const float*)(P.ws + WS_DT);
    const float bias = P.dt_bias[l * 8 + wave], A = -__expf(P.a_log[l * 8 + wave]) * 1.4426950408889634f;
    const float d0 = softplusf(DT[(size_t)(row0 + lane) * 8 + wave] + bias), d1 = softplusf(DT[(size_t)(row0 + 64 + lane) * 8 + wave] + bias);
    float p0 = d0 * A, p1 = d1 * A, tot;
    if (wave < 4) {
#pragma unroll
        for (int o = 1; o < 64; o <<= 1) { const float t0 = bperm(p0, lane - o), t1 = bperm(p1, lane - o); if (lane >= o) { p0 += t0; p1 += t1; } }
        const float tot0 = rdlane(p0, 63); p1 += tot0; tot = rdlane(p1, 63);
    } else {
#pragma unroll
        for (int o = 1; o < 64; o <<= 1) { const float t0 = bperm(p0, lane + o), t1 = bperm(p1, lane + o); if (lane + o < 64) { p0 += t0; p1 += t1; } }
        const float tot1 = rdlane(p1, 0); p0 += tot1; tot = rdlane(p0, 0);
    }
    ARR_dt[wave * 128 + lane] = d0; ARR_dt[wave * 128 + 64 + lane] = d1; ARR_acs[wave * 128 + lane] = p0; ARR_acs[wave * 128 + 64 + lane] = p1;
    return tot;
}
constexpr int XT_LD = 136;
__device__ __forceinline__ int xt_row(int ch) { return ch * XT_LD + (ch >> 3) * 8; }
constexpr int XT_BYTES = (256 * XT_LD + 32 * 8) * 2, BT_BYTES = (128 * XT_LD + 16 * 8) * 2;

#ifndef MIX_CHUNK_REP
#define MIX_CHUNK_REP 1
#endif
#ifndef MIX_POOL_REP
#define MIX_POOL_REP 1
#endif
__device__ __forceinline__ void phase_mixprep(const Params& P, int l, unsigned char* lds, int tid, int lane, int wave, int G, const int bid, const bool do_qk) {
    bf16u* U = (bf16u*)(P.ws + WS_U); bf16u* XBC = (bf16u*)(P.ws + WS_XBC); bf16u* MIX = (bf16u*)(P.ws + WS_MIX);
    const int fr = lane & 15, fq = lane >> 4;
    {
        bf16u* XT = (bf16u*)lds; bf16u* BT = (bf16u*)(lds + XT_BYTES); float* ARR_dt = (float*)(lds + XT_BYTES + BT_BYTES); float* ARR_acs = (float*)(lds + XT_BYTES + BT_BYTES + 4096);
        const int cbk = tid & 63, tq = tid >> 6;
        float cw[5][8], cbv[8];
#pragma unroll
        for (int j = 0; j < 5; ++j)
#pragma unroll
            for (int c = 0; c < 8; ++c) cw[j][c] = P.conv_w[(size_t)(l * 5 + j) * 512 + 8 * cbk + c];
#pragma unroll
        for (int c = 0; c < 8; ++c) cbv[c] = P.conv_b[l * 512 + 8 * cbk + c];
        for (int _cr = 0; _cr < MIX_CHUNK_REP; ++_cr)
        for (int ci = bid; ci < NCHUNK; ci += G) {
            const int b = ci / CPB, cb = ci % CPB, row0 = ci * 128;
            const int seq_lo = b * SEQU + (cb < 2 ? 0 : CTXL), seq_hi = b * SEQU + (cb < 2 ? CTXL : SEQU);
            const float tot = ssd_dt_arrays(P, l, row0, ARR_dt, ARR_acs, lane, wave);
            if (lane == 0) ((float*)(P.ws + WS_CD))[ci * 8 + wave] = __builtin_amdgcn_exp2f(tot);
            float win[5][8], olo[8]; unsigned tp[8][4];
#pragma unroll
            for (int j = 0; j < 4; ++j) { const int rr = row0 + 16 * tq + j - 2; u32x4 raw = {0u, 0u, 0u, 0u};
                if (rr >= seq_lo && rr < seq_hi) raw = *(const u32x4*)(U + (size_t)rr * NU + 512 + 8 * cbk);
                win[j][0] = bflo(raw.x); win[j][1] = bfhi(raw.x); win[j][2] = bflo(raw.y); win[j][3] = bfhi(raw.y); win[j][4] = bflo(raw.z); win[j][5] = bfhi(raw.z); win[j][6] = bflo(raw.w); win[j][7] = bfhi(raw.w); }
#pragma unroll
            for (int p = 0; p < 16; ++p) {
                const int tau = 16 * tq + p, rr = row0 + tau + 2; u32x4 raw = {0u, 0u, 0u, 0u};
                if (rr >= seq_lo && rr < seq_hi) raw = *(const u32x4*)(U + (size_t)rr * NU + 512 + 8 * cbk);
                { const int sl = (p + 4) % 5; win[sl][0] = bflo(raw.x); win[sl][1] = bfhi(raw.x); win[sl][2] = bflo(raw.y); win[sl][3] = bfhi(raw.y); win[sl][4] = bflo(raw.z); win[sl][5] = bfhi(raw.z); win[sl][6] = bflo(raw.w); win[sl][7] = bfhi(raw.w); }
                float o[8];
#pragma unroll
                for (int c = 0; c < 8; ++c) { float acc = cbv[c];
#pragma unroll
                    for (int j = 0; j < 5; ++j) acc += cw[j][c] * win[(p + j) % 5][c];
                    o[c] = siluf(acc); }
                u32x4 w; w.x = pk2(o[0], o[1]); w.y = pk2(o[2], o[3]); w.z = pk2(o[4], o[5]); w.w = pk2(o[6], o[7]);
                *(u32x4*)(XBC + (size_t)(row0 + tau) * 512 + 8 * cbk) = w;
                if ((p & 1) == 0) {
#pragma unroll
                    for (int c = 0; c < 8; ++c) olo[c] = o[c];
                } else {
#pragma unroll
                    for (int c = 0; c < 8; ++c) tp[c][(p & 7) >> 1] = pk2(olo[c], o[c]);
                }
                if ((p & 7) == 7 && cbk < 48) {
                    bf16u* T = (cbk < 32 ? XT + xt_row(8 * cbk) : BT + xt_row(8 * (cbk - 32))) + 16 * tq + (p - 7);
#pragma unroll
                    for (int c = 0; c < 8; ++c) { u32x4 tw = {tp[c][0], tp[c][1], tp[c][2], tp[c][3]}; *(u32x4*)(T + c * XT_LD) = tw; }
                }
            }
            __syncthreads();
            {
                const int h = wave & 3, g = h >> 1;
                f32x4 acc[4][4];
#pragma unroll
                for (int m = 0; m < 4; ++m)
#pragma unroll
                    for (int n = 0; n < 4; ++n) acc[m][n] = (f32x4){0.f, 0.f, 0.f, 0.f};
#pragma unroll
                for (int ks = 0; ks < 4; ++ks) {
                    const int tb = 32 * ks + 8 * fq; float wg[8];
#pragma unroll
                    for (int j = 0; j < 8; ++j) wg[j] = __builtin_amdgcn_exp2f(tot - ARR_acs[wave * 128 + tb + j]) * ARR_dt[wave * 128 + tb + j];
                    bf16x8 Af[4], Bf[4];
#pragma unroll
                    for (int m = 0; m < 4; ++m) { const u32x4 raw = *(const u32x4*)(XT + xt_row(h * 64 + 16 * m + fr) + tb);
                        u32x4 sc; sc.x = pk2(bflo(raw.x) * wg[0], bfhi(raw.x) * wg[1]); sc.y = pk2(bflo(raw.y) * wg[2], bfhi(raw.y) * wg[3]);
                        sc.z = pk2(bflo(raw.z) * wg[4], bfhi(raw.z) * wg[5]); sc.w = pk2(bflo(raw.w) * wg[6], bfhi(raw.w) * wg[7]);
                        Af[m] = __builtin_bit_cast(bf16x8, sc); }
#pragma unroll
                    for (int n = 0; n < 4; ++n) Bf[n] = *(const bf16x8*)(BT + xt_row(g * 64 + 16 * n + fr) + tb);
#pragma unroll
                    for (int m = 0; m < 4; ++m)
#pragma unroll
                        for (int n = 0; n < 4; ++n) acc[m][n] = __builtin_amdgcn_mfma_f32_16x16x32_bf16(Bf[n], Af[m], acc[m][n], 0, 0, 0);
                }
                float* ST = (float*)(P.ws + WS_ST) + (size_t)(ci * 8 + wave) * 4096;
#pragma unroll
                for (int m = 0; m < 4; ++m)
#pragma unroll
                    for (int n = 0; n < 4; ++n) *(f32x4*)(ST + (16 * m + fr) * 64 + 16 * n + 4 * fq) = acc[m][n];
            }
            __syncthreads();
        }
    }
    {
        bf16u* UT = (bf16u*)lds; bf16u* PL = (bf16u*)(lds + 40960); constexpr int PL_LD = 264;
        const int g = wave & 3, th = wave >> 2;
        bf16x8 Wf[4][2];
#pragma unroll
        for (int nt = 0; nt < 4; ++nt)
#pragma unroll
            for (int ks = 0; ks < 2; ++ks) { const float* wp = P.pool_w + (size_t)((l * 4 + g) * 64 + 32 * ks + 8 * fq) * 64 + 16 * nt + fr;
                u32x4 w; w.x = pk2(wp[0], wp[64]); w.y = pk2(wp[128], wp[192]); w.z = pk2(wp[256], wp[320]); w.w = pk2(wp[384], wp[448]); Wf[nt][ks] = __builtin_bit_cast(bf16x8, w); }
        f32x4 pscv[4];
#pragma unroll
        for (int nt = 0; nt < 4; ++nt) pscv[nt] = *(const f32x4*)(P.pool_scale + l * 256 + g * 64 + 16 * nt + 4 * fq);
        const int nx = (NCHUNK > G && NCHUNK - G < G / 2) ? NCHUNK - G : 0, vb = bid - nx, GV = G - nx;
        for (int _pr = 0; _pr < MIX_POOL_REP; ++_pr)
        if (bid >= nx)
        for (int pi = vb; pi < 2 * NCHUNK; pi += GV) {
            const int row0 = pi * 64, b = row0 / SEQU, j0 = row0 % SEQU; const bool isc = j0 < CTXL; if (isc && l == 1) continue;
            const int seq_lo = b * SEQU + (isc ? 0 : CTXL), seq_hi = b * SEQU + (isc ? CTXL : SEQU);
            for (int q = tid; q < 80 * 32; q += 512) { const int rl = q >> 5, cp = q & 31, rr = row0 - 8 + rl;
                u32x4 v = {0u, 0u, 0u, 0u}; if (rr >= seq_lo && rr < seq_hi) v = *(const u32x4*)(U + (size_t)rr * NU + 8 * cp);
                *(u32x4*)(UT + rl * 256 + 8 * cp) = v; }
            __syncthreads();
            { const int ch = tid & 255, hf = tid >> 8, gg = ch >> 6, w = 2 << gg, hw = w >> 1;
              const bf16u* col = UT + ch;
              const int t0 = hf * 32; float sum = 0.f;
              for (int k = -hw; k < hw; ++k) sum += bf2f(col[(t0 + k + 8) * 256]);
#pragma unroll 8
              for (int tt = 0; tt < 32; ++tt) { const int t = t0 + tt, r = row0 + t; int lo = r - hw, hi = lo + w; lo = lo < seq_lo ? seq_lo : lo; hi = hi > seq_hi ? seq_hi : hi;
                  PL[t * PL_LD + ch] = f2bf1(sum * __builtin_amdgcn_rcpf((float)(hi - lo)) - bf2f(col[(t + 8) * 256]));
                  sum += bf2f(col[(t + hw + 8) * 256]) - bf2f(col[(t - hw + 8) * 256]); } }
            __syncthreads();
#pragma unroll
            for (int mt = 0; mt < 2; ++mt) {
                const int t = th * 32 + mt * 16 + fr; bf16x8 Af[2];
#pragma unroll
                for (int ks = 0; ks < 2; ++ks) Af[ks] = *(const bf16x8*)(PL + t * PL_LD + g * 64 + 32 * ks + 8 * fq);
#pragma unroll
                for (int nt = 0; nt < 4; ++nt) { f32x4 acc = {0.f, 0.f, 0.f, 0.f};
#pragma unroll
                    for (int ks = 0; ks < 2; ++ks) acc = __builtin_amdgcn_mfma_f32_16x16x32_bf16(Wf[nt][ks], Af[ks], acc, 0, 0, 0);
                    acc = acc * pscv[nt]; u32x2 w; w.x = pk2(acc.x, acc.y); w.y = pk2(acc.z, acc.w);
                    *(u32x2*)(MIX + (size_t)(row0 + t) * DM + g * 64 + 16 * nt + 4 * fq) = w; } }
            __syncthreads();
        }
    }
    if (do_qk) {
        const int l32 = lane & 31, hw = lane >> 5; const float2* ROPE = (const float2*)(P.ws + WS_ROPE);
        const f32x4 kw = *(const f32x4*)(P.k_norm_w + l * 128 + 4 * l32);
        const int nxk = (NCHUNK > G && NCHUNK - G < G / 2) ? NCHUNK - G : 0; const int gw = bid >= nxk ? (bid - nxk) * 8 + wave : MROWS, NGW = (G - nxk) * 8;
        for (int m0 = gw; m0 < MROWS; m0 += 4 * NGW) {
            u32x2 raw[4];
#pragma unroll
            for (int q = 0; q < 4; ++q) { const int m = m0 + q * NGW; raw[q] = (u32x2){0u, 0u}; if (m < MROWS) raw[q] = *(const u32x2*)(U + (size_t)m * NU + 1536 + 128 * hw + 4 * l32); }
#pragma unroll
            for (int q = 0; q < 4; ++q) { const int m = m0 + q * NGW; if (m >= MROWS) continue;
                const int j = m % SEQU; const bool isc = j < CTXL; const int t = j - CTXL;
                const int pos = l32 < 16 ? (t >> 6) : (t & 63); const int ii = 4 * (l32 & 7);
                f32x4 cs = {1.f, 1.f, 1.f, 1.f}, sn = {0.f, 0.f, 0.f, 0.f};
                if (!isc) { const float2 r0 = ROPE[pos * 32 + ii], r1 = ROPE[pos * 32 + ii + 1], r2 = ROPE[pos * 32 + ii + 2], r3 = ROPE[pos * 32 + ii + 3];
                    cs = (f32x4){r0.x, r1.x, r2.x, r3.x}; sn = (f32x4){r0.y, r1.y, r2.y, r3.y}; }
                bf16u* p = U + (size_t)m * NU + 1536 + 128 * hw + 4 * l32;
                f32x4 v = {bflo(raw[q].x), bfhi(raw[q].x), bflo(raw[q].y), bfhi(raw[q].y)};
                float ss = (v.x * v.x + v.y * v.y) + (v.z * v.z + v.w * v.w);
#pragma unroll
                for (int o = 1; o < 32; o <<= 1) ss += bperm(ss, lane ^ o);
                const float rstd = rsqrtf(ss * (1.0f / 128.0f) + EPSN); v = (v * rstd) * kw;
                f32x4 pr; pr.x = bperm(v.x, lane ^ 8); pr.y = bperm(v.y, lane ^ 8); pr.z = bperm(v.z, lane ^ 8); pr.w = bperm(v.w, lane ^ 8);
                const f32x4 o = (l32 & 8) ? (pr * sn + v * cs) : (v * cs - pr * sn);
                u32x2 w; w.x = pk2(o.x, o.y); w.y = pk2(o.z, o.w); *(u32x2*)p = w; }
        }
    }
}

__device__ __forceinline__ void phase_scan(const Params& P, int tid, int G, const int bid) {
    const float* ST = (const float*)(P.ws + WS_ST); const float* CD = (const float*)(P.ws + WS_CD); bf16u* SP = (bf16u*)(P.ws + WS_SP);
    if (tid < 256)
    for (int e = bid * 256 + tid; e < 65536; e += G * 256) {
        const int combo = e >> 12, idx = e & 4095, b = combo >> 3, dh = combo & 7, d = dh >> 2; float S = 0.f;
        for (int s0 = 0; s0 < CPB; s0 += 10) { float stv[10], cdv[10]; size_t off[10];
#pragma unroll
            for (int q = 0; q < 10; ++q) { const int step = s0 + q; const int cb = d == 0 ? step : (step < 2 ? 1 - step : CPB + 1 - step); const int ci = b * CPB + cb;
                off[q] = (size_t)(ci * 8 + dh) * 4096 + idx; stv[q] = ST[off[q]]; cdv[q] = CD[ci * 8 + dh]; }
#pragma unroll
            for (int q = 0; q < 10; ++q) { SP[off[q]] = f2bf1(S); S = cdv[q] * S + stv[q]; } }
    }
}
#ifndef ATTN_DUP
#define ATTN_DUP 1
#endif
#ifndef ATTN_FIX_LIMIT
#define ATTN_FIX_LIMIT 60.0f
#endif
__device__ __forceinline__ void phase_attn(const Params& P, int l, unsigned char* lds, int G, const int tid, const int bid) {
    const att::bf16* U = (const att::bf16*)(P.ws + WS_U); att::bf16* MIX = (att::bf16*)(P.ws + WS_MIX);
    float mfix;
    { const int lane = tid & 63; const float* qw = P.q_norm_w + l * 128; const float* kw = P.k_norm_w + l * 128;
      float mq = fmaxf(fabsf(qw[lane]), fabsf(qw[lane + 64])), mk = fmaxf(fabsf(kw[lane]), fabsf(kw[lane + 64]));
#pragma unroll
      for (int o = 1; o < 64; o <<= 1) { mq = fmaxf(mq, bperm(mq, lane ^ o)); mk = fmaxf(mk, bperm(mk, lane ^ o)); }
      mfix = 128.0f * 1.001f * mq * mk * (att::SCALE * 1.4426950408889634f); }
    const bool has_cu = (l == 0 && (bid & 31) == 0 && (bid >> 5) < 8);
    if (mfix <= ATTN_FIX_LIMIT) {
#pragma unroll 1
    for (int u0 = has_cu ? -1 : (int)bid; u0 < 512 * ATTN_DUP; u0 = (u0 < 0 ? (int)bid : u0 + G)) {
        const int u = u0 < 0 ? u0 : (u0 & 511);
        size_t r0, rq; int h, kvh, seq;
        if (u < 0) { const int cu = bid >> 5; const int b = cu >> 2; h = cu & 3; kvh = h >> 1; r0 = (size_t)b * SEQU; rq = r0; seq = CTXL; }
        else { const int xcd = u & 7, slot = (u >> 3) & 31, i = u >> 8, combo = xcd >> 1, b = combo >> 1; kvh = combo & 1; h = 2 * kvh + (xcd & 1); const int qb = i * 32 + slot;
            r0 = (size_t)b * SEQU; rq = r0 + CTXL + (size_t)qb * 256; seq = SEQU; }
        att::attn_dense_body_dma<att::bf16>(U + rq * NU + 1024 + h * 128, U + r0 * NU + 1536 + kvh * 128, U + r0 * NU + 1792 + kvh * 128, MIX + rq * DM + 512 + h * 128, seq, (char*)lds, tid, P.q_norm_w + l * 128, (const float2*)(P.ws + WS_ROPE), u < 0 ? -1 : (int)(rq - r0 - CTXL));
        __syncthreads();
    }
    } else {
#pragma unroll 1
    for (int u0 = has_cu ? -1 : (int)bid; u0 < 512 * ATTN_DUP; u0 = (u0 < 0 ? (int)bid : u0 + G)) {
        const int u = u0 < 0 ? u0 : (u0 & 511);
        size_t r0, rq; int h, kvh, seq;
        if (u < 0) { const int cu = bid >> 5; const int b = cu >> 2; h = cu & 3; kvh = h >> 1; r0 = (size_t)b * SEQU; rq = r0; seq = CTXL; }
        else { const int xcd = u & 7, slot = (u >> 3) & 31, i = u >> 8, combo = xcd >> 1, b = combo >> 1; kvh = combo & 1; h = 2 * kvh + (xcd & 1); const int qb = i * 32 + slot;
            r0 = (size_t)b * SEQU; rq = r0 + CTXL + (size_t)qb * 256; seq = SEQU; }
        att::attn_dense_body<att::bf16, false>(U + rq * NU + 1024 + h * 128, U + r0 * NU + 1536 + kvh * 128, U + r0 * NU + 1792 + kvh * 128, MIX + rq * DM + 512 + h * 128, seq, (char*)lds, tid, P.q_norm_w + l * 128, (const float2*)(P.ws + WS_ROPE), u < 0 ? -1 : (int)(rq - r0 - CTXL));
        __syncthreads();
    }
    }
}

#ifndef SSD_STAGE_REP
#define SSD_STAGE_REP 1
#endif
#ifndef SSD_HEAD_REP
#define SSD_HEAD_REP 1
#endif
__device__ __forceinline__ void phase_ssdout(const Params& P, int l, unsigned char* lds, int tid, int lane, int wave, int G, const int bid) {
    const bf16u* U = (const bf16u*)(P.ws + WS_U); const bf16u* XBC = (const bf16u*)(P.ws + WS_XBC); bf16u* MIX = (bf16u*)(P.ws + WS_MIX); const bf16u* SP = (const bf16u*)(P.ws + WS_SP);
    bf16u* XT = (bf16u*)lds; float* ARR_dt = (float*)(lds + XT_BYTES); float* ARR_acs = (float*)(lds + XT_BYTES + 4096); bf16u* BC = (bf16u*)(lds + XT_BYTES + 8192);
    constexpr int BC_LD = 264;
    const int fr = lane & 15, fq = lane >> 4;
    for (int ci = bid; ci < NCHUNK; ci += G) {
        const int cb = ci % CPB, row0 = ci * 128; if (l == 1 && cb < 2) continue;
        (void)ssd_dt_arrays(P, l, row0, ARR_dt, ARR_acs, lane, wave);
        for (int _sr = 0; _sr < SSD_STAGE_REP; ++_sr) {
            const int cp = tid & 63, rg = tid >> 6;
#pragma unroll
            for (int k = 0; k < 2; ++k) { const int tb0 = 16 * rg + 8 * k; u32x4 w[8];
#pragma unroll
                for (int j = 0; j < 8; ++j) w[j] = *(const u32x4*)(XBC + (size_t)(row0 + tb0 + j) * 512 + 8 * cp);
                if (cp < 32) { bf16u* T = XT + xt_row(8 * cp) + tb0;
#pragma unroll
                    for (int c2 = 0; c2 < 4; ++c2) {
                        u32x4 lo, hi;
                        lo.x = (w[0][c2] & 0xffffu) | (w[1][c2] << 16); lo.y = (w[2][c2] & 0xffffu) | (w[3][c2] << 16); lo.z = (w[4][c2] & 0xffffu) | (w[5][c2] << 16); lo.w = (w[6][c2] & 0xffffu) | (w[7][c2] << 16);
                        hi.x = (w[0][c2] >> 16) | (w[1][c2] & 0xffff0000u); hi.y = (w[2][c2] >> 16) | (w[3][c2] & 0xffff0000u); hi.z = (w[4][c2] >> 16) | (w[5][c2] & 0xffff0000u); hi.w = (w[6][c2] >> 16) | (w[7][c2] & 0xffff0000u);
                        *(u32x4*)(T + (2 * c2) * XT_LD) = lo; *(u32x4*)(T + (2 * c2 + 1) * XT_LD) = hi; } }
                else {
#pragma unroll
                    for (int j = 0; j < 8; ++j) *(u32x4*)(BC + (size_t)(tb0 + j) * BC_LD + 8 * (cp - 32)) = w[j]; } }
        }
        __syncthreads();
        const int tau = 16 * wave + fr, r = row0 + tau;
        f32x4 Yp[4]; float ssq_p = 0.f;
#pragma unroll
        for (int pt = 0; pt < 4; ++pt) Yp[pt] = (f32x4){0.f, 0.f, 0.f, 0.f};
#pragma unroll 1
        for (int h0 = 0; h0 < 4 * SSD_HEAD_REP; ++h0) {
            const int h = h0 & 3, g = h >> 1;
            f32x4 Y[4];
#pragma unroll
            for (int pt = 0; pt < 4; ++pt) Y[pt] = (f32x4){0.f, 0.f, 0.f, 0.f};
            bf16x8 Cf[2];
            bf16x8 Sf[2][4][2];
#pragma unroll
            for (int d = 0; d < 2; ++d) { const bf16u* sp = SP + (size_t)(ci * 8 + d * 4 + h) * 4096 + fr * 64 + 8 * fq;
#pragma unroll
                for (int pt = 0; pt < 4; ++pt)
#pragma unroll
                    for (int ks = 0; ks < 2; ++ks) Sf[d][pt][ks] = *(const bf16x8*)(sp + (16 * pt) * 64 + 32 * ks); }
            const float dsk = P.d_skip[l * 8 + h] + P.d_skip[l * 8 + 4 + h];
            u32x2 xrv[4], zrv[4];
            { const bf16u* xrp = XBC + (size_t)r * 512 + h * 64 + 4 * fq; const bf16u* zrp = U + (size_t)r * NU + 256 + h * 64 + 4 * fq;
#pragma unroll
              for (int pt = 0; pt < 4; ++pt) { xrv[pt] = *(const u32x2*)(xrp + 16 * pt); zrv[pt] = *(const u32x2*)(zrp + 16 * pt); } }
            const bf16u* cp = BC + (size_t)tau * BC_LD + 128 + 64 * g + 8 * fq;
#pragma unroll
            for (int ks = 0; ks < 2; ++ks) Cf[ks] = *(const bf16x8*)(cp + 32 * ks);
            f32x4 Gm[8];
            const bf16u* bp = BC + (size_t)fr * BC_LD + 64 * g + 8 * fq;
#pragma unroll
            for (int nt = 0; nt < 8; ++nt) { Gm[nt] = (f32x4){0.f, 0.f, 0.f, 0.f};
#pragma unroll
                for (int ks = 0; ks < 2; ++ks) { const bf16x8 Bf = *(const bf16x8*)(bp + nt * 16 * BC_LD + 32 * ks);
                    Gm[nt] = __builtin_amdgcn_mfma_f32_16x16x32_bf16(Bf, Cf[ks], Gm[nt], 0, 0, 0); } }
            const float* acf = ARR_acs + h * 128; const float* acb = ARR_acs + (4 + h) * 128; const float* dtfp = ARR_dt + h * 128; const float* dtbp = ARR_dt + (4 + h) * 128;
            const float af_t = acf[tau], ab_t = acb[tau];
            int frl = fr; asm volatile("" : "+v"(frl));
            const bf16u* xtp = XT + xt_row(h * 64 + fr) + 4 * fq;
#pragma unroll
            for (int ks = 0; ks < 4; ++ks) {
                float mv[8];
#pragma unroll
                for (int hf = 0; hf < 2; ++hf) { const int nt = 2 * ks + hf, rho0 = 16 * nt + 4 * fq;
                    if (nt != wave) {
                        const bool lower = nt < wave; const float a_t = lower ? af_t : ab_t;
                        const f32x4 a_r = *(const f32x4*)((lower ? acf : acb) + rho0), dt_r = *(const f32x4*)((lower ? dtfp : dtbp) + rho0);
#pragma unroll
                        for (int i = 0; i < 4; ++i) mv[hf * 4 + i] = Gm[nt][i] * (__builtin_amdgcn_exp2f(a_t - a_r[i]) * dt_r[i]);
                    } else {
                        const f32x4 af_r = *(const f32x4*)(acf + rho0), ab_r = *(const f32x4*)(acb + rho0);
                        const f32x4 dtf = *(const f32x4*)(dtfp + rho0), dtb = *(const f32x4*)(dtbp + rho0);
#pragma unroll
                        for (int i = 0; i < 4; ++i) { const bool lw = (4 * fq + i) < frl;
                            const float arg = lw ? af_t - af_r[i] : ab_t - ab_r[i]; float f = __builtin_amdgcn_exp2f(arg) * (lw ? dtf[i] : dtb[i]);
                            if ((4 * fq + i) == frl) f = dtf[i] + dtb[i];
                            mv[hf * 4 + i] = Gm[nt][i] * f; }
                    } }
                u32x4 mw; mw.x = pk2(mv[0], mv[1]); mw.y = pk2(mv[2], mv[3]); mw.z = pk2(mv[4], mv[5]); mw.w = pk2(mv[6], mv[7]);
                const bf16x8 Mf = __builtin_bit_cast(bf16x8, mw);
#pragma unroll
                for (int pt = 0; pt < 4; ++pt) { const bf16u* xp = xtp + (16 * pt) * XT_LD + 2 * pt * 8 + 32 * ks;
                    const u32x2 x0 = *(const u32x2*)xp, x1 = *(const u32x2*)(xp + 16); const u32x4 xw = {x0.x, x0.y, x1.x, x1.y};
                    Y[pt] = __builtin_amdgcn_mfma_f32_16x16x32_bf16(__builtin_bit_cast(bf16x8, xw), Mf, Y[pt], 0, 0, 0); }
            }
#pragma unroll
            for (int d = 0; d < 2; ++d) {
                const float e = __builtin_amdgcn_exp2f(d == 0 ? af_t : ab_t);
#pragma unroll
                for (int pt = 0; pt < 4; ++pt) { f32x4 Z = {0.f, 0.f, 0.f, 0.f};
#pragma unroll
                    for (int ks = 0; ks < 2; ++ks) Z = __builtin_amdgcn_mfma_f32_16x16x32_bf16(Sf[d][pt][ks], Cf[ks], Z, 0, 0, 0);
                    Y[pt] += Z * e; }
            }
            float ssq = 0.f;
#pragma unroll
            for (int pt = 0; pt < 4; ++pt) {
                const u32x2 xr = xrv[pt], zr = zrv[pt];
                f32x4 y = Y[pt]; y.x += dsk * bflo(xr.x); y.y += dsk * bfhi(xr.x); y.z += dsk * bflo(xr.y); y.w += dsk * bfhi(xr.y);
                y.x *= siluf(bflo(zr.x)); y.y *= siluf(bfhi(zr.x)); y.z *= siluf(bflo(zr.y)); y.w *= siluf(bfhi(zr.y));
                Y[pt] = y; ssq += (y.x * y.x + y.y * y.y) + (y.z * y.z + y.w * y.w); }
            if ((h & 1) == 0) {
#pragma unroll
                for (int pt = 0; pt < 4; ++pt) Yp[pt] = Y[pt];
                ssq_p = ssq;
            } else {
                ssq += ssq_p; ssq += bperm(ssq, lane ^ 16); ssq += bperm(ssq, lane ^ 32); ssq = rsqrtf(ssq * (1.0f / 128.0f) + EPSN);
                const float* nwp = P.ssd_norm_w + l * 256 + (h - 1) * 64 + 4 * fq; bf16u* op = MIX + (size_t)r * DM + 256 + (h - 1) * 64 + 4 * fq;
#pragma unroll
                for (int pt = 0; pt < 4; ++pt) { const f32x4 o0 = Yp[pt] * ssq * *(const f32x4*)(nwp + 16 * pt), o1 = Y[pt] * ssq * *(const f32x4*)(nwp + 64 + 16 * pt);
                    u32x2 w0, w1; w0.x = pk2(o0.x, o0.y); w0.y = pk2(o0.z, o0.w); w1.x = pk2(o1.x, o1.y); w1.y = pk2(o1.z, o1.w);
                    *(u32x2*)(op + 16 * pt) = w0; *(u32x2*)(op + 64 + 16 * pt) = w1; }
            }
        }
        __syncthreads();
    }
}


template <int K, class RT, class OT>
__device__ __forceinline__ void ctx_gemm_resid(const bf16u* A  , const bf16u* Wt  , const RT* res_ctx, OT* out_ctx, const float* gate_ctx,
                                               unsigned char* lds, int tid, int lane, int wave, int G, int bid) {
    constexpr int KW = K / 8, PLD = 68; static_assert(KW % 32 == 0, "K/8 must be a multiple of the MFMA k-step");
    const int fr = lane & 15, fq = lane >> 4; float* PS = (float*)lds;
    for (int it = bid; it < 128; it += G) {
        const int mt = it >> 4, nt64 = it & 15;
        const bf16u* ap[4]; const bf16u* bp[4];
#pragma unroll
        for (int q = 0; q < 4; ++q) { const int c = mt * 64 + q * 16 + fr;
            ap[q] = A + ((size_t)(c >> 8) * SEQU + (c & 255)) * K + wave * KW + 8 * fq;
            bp[q] = Wt + (size_t)(nt64 * 64 + q * 16 + fr) * K + wave * KW + 8 * fq; }
        f32x4 acc[4][4];
#pragma unroll
        for (int mi = 0; mi < 4; ++mi)
#pragma unroll
            for (int ni = 0; ni < 4; ++ni) acc[mi][ni] = (f32x4){0.f, 0.f, 0.f, 0.f};
#pragma unroll 4
        for (int k = 0; k < KW; k += 32) { bf16x8 af[4], bfr[4];
#pragma unroll
            for (int q = 0; q < 4; ++q) { af[q] = *(const bf16x8*)(ap[q] + k); bfr[q] = *(const bf16x8*)(bp[q] + k); }
#pragma unroll
            for (int mi = 0; mi < 4; ++mi)
#pragma unroll
                for (int ni = 0; ni < 4; ++ni) acc[mi][ni] = __builtin_amdgcn_mfma_f32_16x16x32_bf16(bfr[ni], af[mi], acc[mi][ni], 0, 0, 0); }
#pragma unroll
        for (int mi = 0; mi < 4; ++mi)
#pragma unroll
            for (int ni = 0; ni < 4; ++ni) *(f32x4*)(PS + (size_t)(wave * 64 + 16 * mi + fr) * PLD + 16 * ni + 4 * fq) = acc[mi][ni];
        __syncthreads();
        { const int row = tid >> 3, c8 = (tid & 7) * 8; f32x4 s0 = {0.f, 0.f, 0.f, 0.f}, s1 = s0;
#pragma unroll
          for (int w = 0; w < 8; ++w) { s0 += *(const f32x4*)(PS + (size_t)(w * 64 + row) * PLD + c8); s1 += *(const f32x4*)(PS + (size_t)(w * 64 + row) * PLD + c8 + 4); }
          const int col = nt64 * 64 + c8; const size_t o = (size_t)(mt * 64 + row) * DM + col; f32x4 r0, r1; pg8::ld8(res_ctx + o, r0, r1);
          pg8::st8(out_ctx + o, r0 + *(const f32x4*)(gate_ctx + col) * s0, r1 + *(const f32x4*)(gate_ctx + col + 4) * s1); }
        __syncthreads();
    }
}

#define LAS __attribute__((address_space(3)))
#define XB_TMO      128
#define XB_XCNT(j)  (256  + 64 * (j))
#define XB_XSUB(j)  (1280 + 64 * (j))
#define XB_XGEN(j)  (2304 + 64 * (j))
#define XB_TOP      3328
#define XB_TOPGEN   3392
#define XCD_BAR_WORDS 3456
#define XB_SPIN_CAP (1u << 18)

__device__ __forceinline__ unsigned xb_ld(unsigned* p)              { return __hip_atomic_load(p, __ATOMIC_RELAXED, __HIP_MEMORY_SCOPE_AGENT); }
__device__ __forceinline__ unsigned xb_add(unsigned* p, unsigned v) { return __hip_atomic_fetch_add(p, v, __ATOMIC_RELAXED, __HIP_MEMORY_SCOPE_AGENT); }
__device__ __forceinline__ unsigned xb_xcc_id() { return (unsigned)__builtin_amdgcn_s_getreg((3 << 11) | 20) & 0xFu; }
#define XB_SPIN(cond, bar) do { unsigned _sp = 0; while (cond) { __builtin_amdgcn_s_sleep(1); \
    if ((++_sp & 255u) == 0u) { if (xb_ld(&(bar)[XB_TMO])) break; if (_sp > XB_SPIN_CAP) { atomicAdd(&(bar)[XB_TMO], 1u); break; } } } } while (0)

struct XcdBarrier {
    unsigned* bar; unsigned x;
    volatile LAS unsigned* st;
};

__device__ __forceinline__ XcdBarrier xcd_barrier_post(unsigned* bar, volatile LAS unsigned* st, const int tid_) {
    XcdBarrier b; b.bar = bar; b.x = xb_xcc_id(); b.st = st;
    if (tid_ == 0) (void)xb_add(&bar[XB_XCNT(b.x)], 1u);
    return b;
}
__device__ __forceinline__ void xcd_barrier_complete(unsigned* bar, unsigned x, unsigned& nloc, unsigned& nx) {
    const unsigned G = gridDim.x * gridDim.y * gridDim.z;
    unsigned sum, cnt, mine, sp = 0u;
    for (;;) {
        sum = 0u; cnt = 0u; mine = 0u;
#pragma unroll
        for (unsigned j = 0; j < 16; ++j) { const unsigned c = xb_ld(&bar[XB_XCNT(j)]); sum += c; cnt += (c > 0u) ? 1u : 0u; mine = (j == x) ? c : mine; }
        if (sum == G) break;
        __builtin_amdgcn_s_sleep(1);
        if ((++sp & 255u) == 0u) { if (xb_ld(&bar[XB_TMO])) break; if (sp > XB_SPIN_CAP) { atomicAdd(&bar[XB_TMO], 1u); break; } }
    }
    nloc = mine > 0u ? mine : 1u; nx = cnt > 0u ? cnt : 1u;
}

__device__ __forceinline__ void xcd_barrier(const XcdBarrier& b, const int tid_) {
    asm volatile("s_waitcnt vmcnt(0)" ::: "memory");
    __syncthreads();
    if (tid_ == 0) {
        unsigned* bar = b.bar;
        __builtin_amdgcn_s_waitcnt(0);
        unsigned nloc = b.st[0], nx = b.st[1];
        if (nloc == 0u) { xcd_barrier_complete(bar, b.x, nloc, nx); b.st[0] = nloc; b.st[1] = nx; }
        const unsigned old = xb_add(&bar[XB_XSUB(b.x)], 1u);
        const unsigned gen = old / nloc;
        if (old + 1u == (gen + 1u) * nloc) {
            __builtin_amdgcn_fence(__ATOMIC_RELEASE, "agent");
            asm volatile("s_waitcnt vmcnt(0)" ::: "memory");
            const unsigned og = xb_add(&bar[XB_TOP], 1u);
            const unsigned tg = og / nx;
            if (og + 1u == (tg + 1u) * nx) xb_add(&bar[XB_TOPGEN], 1u);
            else XB_SPIN(xb_ld(&bar[XB_TOPGEN]) == tg, bar);
            __builtin_amdgcn_fence(__ATOMIC_ACQUIRE, "agent");
            xb_add(&bar[XB_XGEN(b.x)], 1u);
            asm volatile("s_waitcnt vmcnt(0)" ::: "memory");
        } else {
            XB_SPIN(xb_ld(&bar[XB_XGEN(b.x)]) == gen, bar);
            __builtin_amdgcn_fence(__ATOMIC_ACQUIRE, "agent");
            asm volatile("s_waitcnt vmcnt(0)" ::: "memory");
        }
    }
    __syncthreads();
}

typedef unsigned long long u64t;
__device__ __forceinline__ u64t ld_tab(const __attribute__((address_space(3))) u64t* T, int i) { const u64t v = T[i];
    return (u64t)(unsigned)__builtin_amdgcn_readfirstlane((int)(unsigned)v) | ((u64t)(unsigned)__builtin_amdgcn_readfirstlane((int)(unsigned)(v >> 32)) << 32); }
#define GLB(T, v) ((T*)(__attribute__((address_space(1))) T*)(v))
__device__ __forceinline__ Params load_params(const __attribute__((address_space(3))) u64t* T, int lo, int hi) {
    Params Q;
    Q.x = GLB(const float, ld_tab(T, 0)); Q.c = GLB(const float, ld_tab(T, 1)); Q.ctx = GLB(const float, ld_tab(T, 2)); Q.c_ctx = GLB(const float, ld_tab(T, 3)); Q.norm1_w = GLB(const float, ld_tab(T, 4));
    Q.norm2_w = GLB(const float, ld_tab(T, 5)); Q.w_mod = GLB(const float, ld_tab(T, 6)); Q.b_mod = GLB(const float, ld_tab(T, 7)); Q.w_in = GLB(const float, ld_tab(T, 8)); Q.pool_w = GLB(const float, ld_tab(T, 9));
    Q.pool_scale = GLB(const float, ld_tab(T, 10)); Q.conv_w = GLB(const float, ld_tab(T, 11)); Q.conv_b = GLB(const float, ld_tab(T, 12)); Q.dt_bias = GLB(const float, ld_tab(T, 13)); Q.a_log = GLB(const float, ld_tab(T, 14));
    Q.d_skip = GLB(const float, ld_tab(T, 15)); Q.ssd_norm_w = GLB(const float, ld_tab(T, 16)); Q.q_norm_w = GLB(const float, ld_tab(T, 17)); Q.k_norm_w = GLB(const float, ld_tab(T, 18)); Q.w_out = GLB(const float, ld_tab(T, 19));
    Q.w1 = GLB(const float, ld_tab(T, 20)); Q.w3 = GLB(const float, ld_tab(T, 21)); Q.w2 = GLB(const float, ld_tab(T, 22)); Q.out = GLB(float, ld_tab(T, 23)); Q.ws = GLB(unsigned char, ld_tab(T, 24)); Q.ph_lo = lo; Q.ph_hi = hi;
    return Q;
}
__global__ void __launch_bounds__(512, 2) hybrid_fwd(Params P0) {
    extern __shared__ __attribute__((aligned(16))) unsigned char lds[];
    cg::grid_group grid = cg::this_grid();
    PG8_LAS unsigned char* ldsl = (PG8_LAS unsigned char*)lds;
    PG8_LAS u64t* TAB = (PG8_LAS u64t*)(ldsl + LDS_TAB);
    const int lo = P0.ph_lo, hi = P0.ph_hi;
    const int wave0 = __builtin_amdgcn_readfirstlane((int)threadIdx.x >> 6);
#define FRESH_TID(name) unsigned name##z_ = 0u; asm volatile("" : "+s"(name##z_)); int name = wave0 * 64 + (int)__builtin_amdgcn_mbcnt_hi(~0u, __builtin_amdgcn_mbcnt_lo(~0u, name##z_)); asm volatile("" : "+v"(name));
    if (threadIdx.x == 0) {
        TAB[0] = (u64t)P0.x; TAB[1] = (u64t)P0.c; TAB[2] = (u64t)P0.ctx; TAB[3] = (u64t)P0.c_ctx; TAB[4] = (u64t)P0.norm1_w; TAB[5] = (u64t)P0.norm2_w; TAB[6] = (u64t)P0.w_mod; TAB[7] = (u64t)P0.b_mod;
        TAB[8] = (u64t)P0.w_in; TAB[9] = (u64t)P0.pool_w; TAB[10] = (u64t)P0.pool_scale; TAB[11] = (u64t)P0.conv_w; TAB[12] = (u64t)P0.conv_b; TAB[13] = (u64t)P0.dt_bias; TAB[14] = (u64t)P0.a_log;
        TAB[15] = (u64t)P0.d_skip; TAB[16] = (u64t)P0.ssd_norm_w; TAB[17] = (u64t)P0.q_norm_w; TAB[18] = (u64t)P0.k_norm_w; TAB[19] = (u64t)P0.w_out; TAB[20] = (u64t)P0.w1; TAB[21] = (u64t)P0.w3;
        TAB[22] = (u64t)P0.w2; TAB[23] = (u64t)P0.out; TAB[24] = (u64t)P0.ws;
        ((PG8_LAS unsigned*)(ldsl + LDS_TAB + 256))[0] = 0u; ((PG8_LAS unsigned*)(ldsl + LDS_TAB + 256))[1] = 0u;
    }
    __syncthreads();
    if (blockIdx.x == 0) { for (int i = threadIdx.x; i < 4096; i += 512) ((unsigned*)(P0.ws + WS_BAR))[i] = 0u; }
    XcdBarrier bar; bar.bar = (unsigned*)(P0.ws + WS_BAR); bar.x = 0; bar.st = (volatile LAS unsigned*)(ldsl + LDS_TAB + 256);
#ifndef TMASK
#define TMASK 0xFFFF
#endif
#define EN(t) (((TMASK) >> (t)) & 1)
#ifndef DUPMASK
#define DUPMASK 0
#endif
#ifndef DUPMASK0
#define DUPMASK0 DUPMASK
#endif
#ifndef DUPMASK1
#define DUPMASK1 DUPMASK
#endif
#define NREP(t) (((((l_ == 0 ? (DUPMASK0) : (DUPMASK1))) >> (t)) & 1) ? 2 : 1)
#define IN(k) (lo <= (k) && (k) < hi)
#ifndef SCAN_DUP
#define SCAN_DUP 1
#endif
#ifndef BAR_DUP
#define BAR_DUP 1
#endif
#define SEAM(k) do { if (IN(k) && IN((k) + 1)) { if ((k) == 0) { grid.sync(); FRESH_TID(tb_); bar = xcd_barrier_post(bar.bar, bar.st, tb_); } else { FRESH_TID(tb_); for (int _b = 0; _b < BAR_DUP; ++_b) xcd_barrier(bar, tb_); } } } while (0)
#define FRESH() FRESH_TID(tid) int bid = blockIdx.x; asm volatile("" : "+s"(bid)); int G = gridDim.x; asm volatile("" : "+s"(G)); const int lane = tid & 63, wave = __builtin_amdgcn_readfirstlane(tid >> 6); (void)lane; (void)wave; \
    const Params P = load_params(TAB, lo, hi); unsigned char* const ws = P.ws; (void)ws;
    constexpr int l_ = 0;
    if (EN(0) && IN(0)) { for (int rep = 0; rep < NREP(0); ++rep) { FRESH(); phase_prep(P, lds, tid, lane, wave, G, bid); } } SEAM(0);
    if (EN(1) && IN(1)) { for (int rep = 0; rep < NREP(1); ++rep) { FRESH(); phase_modreduce(P, tid, G, bid); } } SEAM(1);
    { constexpr int l = 0; constexpr int l_ = 0;
        const int pb = 2 + 9 * l; const int skip = l;
#define LAYER_PTRS() const float* mod = (const float*)(ws + WS_MOD) + (size_t)l * 3 * NMODV; (void)mod; \
        bf16u* XSL = (bf16u*)(ws + WS_XSL); bf16u* XSC = (bf16u*)(ws + WS_XSC); (void)XSL; (void)XSC; bf16u* HN = (bf16u*)(ws + WS_HN); (void)HN;
        if (EN(2) && IN(pb + 0)) { for (int rep = 0; rep < NREP(2); ++rep) { FRESH(); LAYER_PTRS(); phase_norm<float>(P.x, P.ctx, P.norm1_w + l * DM, mod, 0, 1024, HN, 0, lane, wave, G, bid); } } SEAM(pb + 0);
        if (EN(3) && IN(pb + 1)) { for (int rep = 0; rep < NREP(3); ++rep) { FRESH(); LAYER_PTRS(); pg8::Gemm g{HN, (const bf16u*)(ws + WS_WIN) + (size_t)l * NIN * 1024, MROWS, NIN, DM}; pg8::OrderX S; S.init(MROWS / 256, NIN, G, bid, 0);
            pg8::EpiInProj E{(bf16u*)(ws + WS_U), (float*)(ws + WS_DT)};
            pg8::gemm_phase<pg8::EpiInProj, pg8::OrderX, true, true>(ldsl, g, S, E, tid); } } SEAM(pb + 1);
        if (EN(4) && IN(pb + 2)) { for (int rep = 0; rep < NREP(4); ++rep) { FRESH(); phase_mixprep(P, l, lds, tid, lane, wave, G, bid, rep == NREP(4) - 1); } } SEAM(pb + 2);
        if (EN(5) && IN(pb + 3)) { for (int rep = 0; rep < NREP(5); ++rep) { { FRESH(); for (int _s = 0; _s < SCAN_DUP; ++_s) phase_scan(P, tid, G, bid); } __syncthreads(); { FRESH(); phase_attn(P, l, lds, G, tid, bid); } } } SEAM(pb + 3);
        if (EN(6) && IN(pb + 4)) { for (int rep = 0; rep < NREP(6); ++rep) { FRESH(); phase_ssdout(P, l, lds, tid, lane, wave, G, bid); } } SEAM(pb + 4);
        if (EN(7) && IN(pb + 5)) { for (int rep = 0; rep < NREP(7); ++rep) { FRESH(); LAYER_PTRS(); if (l == 0) { ctx_gemm_resid<DM, float, bf16u>((const bf16u*)(ws + WS_MIX), (const bf16u*)(ws + WS_WOUT), P.ctx, XSC, mod + 2048 + 2 * NMODV, lds, tid, lane, wave, G, bid); __syncthreads(); }
            pg8::Gemm g{(const bf16u*)(ws + WS_MIX), (const bf16u*)(ws + WS_WOUT) + (size_t)l * 1024 * 1024, MROWS, DM, DM}; pg8::OrderX S; S.init(128, DM, G, bid, 1);
            pg8::EpiResid<float, bf16u> E{P.x, P.ctx, XSL, XSC, mod + 2048};
            pg8::gemm_phase<pg8::EpiResid<float, bf16u>, pg8::OrderX, true, true>(ldsl, g, S, E, tid); } } SEAM(pb + 5);
        if (EN(8) && IN(pb + 6)) { for (int rep = 0; rep < NREP(8); ++rep) { FRESH(); LAYER_PTRS(); phase_norm<bf16u>(XSL, XSC, P.norm2_w + l * DM, mod, 3072, 4096, HN, skip, lane, wave, G, bid); } } SEAM(pb + 6);
        if (EN(9) && IN(pb + 7)) { for (int rep = 0; rep < NREP(9); ++rep) { FRESH(); LAYER_PTRS(); pg8::Gemm g{HN, (const bf16u*)(ws + WS_W13) + (size_t)l * 2 * DFF * 1024, MROWS, 2 * DFF, DM}; pg8::OrderX S; S.init(skip ? 128 : 130, 2 * DFF, G, bid, skip);
            pg8::EpiSwiGLU E{(bf16u*)(ws + WS_ACT)};
            pg8::gemm_phase<pg8::EpiSwiGLU, pg8::OrderX, true, true>(ldsl, g, S, E, tid);
            if (l == 0) { const int nwg = 130 * 22, R = (nwg + G - 1) / G, fi = nwg - (R - 1) * G;
                if (nwg % G == 0) prep_layer1_weights(P, lds, lane, wave, bid, G); else if (bid >= fi) prep_layer1_weights(P, lds, lane, wave, bid - fi, G - fi); } } } SEAM(pb + 7);
        if (EN(10) && IN(pb + 8)) { for (int rep = 0; rep < NREP(10); ++rep) { FRESH(); LAYER_PTRS(); if (l == 0) { ctx_gemm_resid<DFF, bf16u, bf16u>((const bf16u*)(ws + WS_ACT), (const bf16u*)(ws + WS_W2), XSC, XSC, mod + 5120 + 2 * NMODV, lds, tid, lane, wave, G, bid); __syncthreads(); }
            pg8::Gemm g{(const bf16u*)(ws + WS_ACT), (const bf16u*)(ws + WS_W2) + (size_t)l * 1024 * DFF, MROWS, DM, DFF}; pg8::OrderX S; S.init(128, DM, G, bid, 1);
            pg8::EpiResid<bf16u, bf16u> E{XSL, XSC, XSL, XSC, mod + 5120};
            pg8::gemm_phase<pg8::EpiResid<bf16u, bf16u>, pg8::OrderX, true, true>(ldsl, g, S, E, tid); } } SEAM(pb + 8);
        }
    { constexpr int l = 1; constexpr int l_ = 1;
        const int pb = 2 + 9 * l; const int skip = l;
#undef LAYER_PTRS
#define LAYER_PTRS() const float* mod = (const float*)(ws + WS_MOD) + (size_t)l * 3 * NMODV; (void)mod; \
        bf16u* XSL = (bf16u*)(ws + WS_XSL); bf16u* XSC = (bf16u*)(ws + WS_XSC); (void)XSL; (void)XSC; bf16u* HN = (bf16u*)(ws + WS_HN); (void)HN;
        if (EN(2) && IN(pb + 0)) { for (int rep = 0; rep < NREP(2); ++rep) { FRESH(); LAYER_PTRS(); phase_norm<bf16u>(XSL, XSC, P.norm1_w + l * DM, mod, 0, 1024, HN, 0, lane, wave, G, bid); } } SEAM(pb + 0);
        if (EN(3) && IN(pb + 1)) { for (int rep = 0; rep < NREP(3); ++rep) { FRESH(); LAYER_PTRS(); pg8::Gemm g{HN, (const bf16u*)(ws + WS_WIN) + (size_t)l * NIN * 1024, MROWS, NIN, DM}; pg8::OrderX S; S.init(MROWS / 256, NIN, G, bid, 0);
            pg8::EpiInProj E{(bf16u*)(ws + WS_U), (float*)(ws + WS_DT)};
            pg8::gemm_phase<pg8::EpiInProj, pg8::OrderX, true, true>(ldsl, g, S, E, tid); } } SEAM(pb + 1);
        if (EN(4) && IN(pb + 2)) { for (int rep = 0; rep < NREP(4); ++rep) { FRESH(); phase_mixprep(P, l, lds, tid, lane, wave, G, bid, rep == NREP(4) - 1); } } SEAM(pb + 2);
        if (EN(5) && IN(pb + 3)) { for (int rep = 0; rep < NREP(5); ++rep) { { FRESH(); for (int _s = 0; _s < SCAN_DUP; ++_s) phase_scan(P, tid, G, bid); } __syncthreads(); { FRESH(); phase_attn(P, l, lds, G, tid, bid); } } } SEAM(pb + 3);
        if (EN(6) && IN(pb + 4)) { for (int rep = 0; rep < NREP(6); ++rep) { FRESH(); phase_ssdout(P, l, lds, tid, lane, wave, G, bid); } } SEAM(pb + 4);
        if (EN(7) && IN(pb + 5)) { for (int rep = 0; rep < NREP(7); ++rep) { FRESH(); LAYER_PTRS(); if (l == 0) { ctx_gemm_resid<DM, bf16u, bf16u>((const bf16u*)(ws + WS_MIX), (const bf16u*)(ws + WS_WOUT), XSC, XSC, mod + 2048 + 2 * NMODV, lds, tid, lane, wave, G, bid); __syncthreads(); }
            pg8::Gemm g{(const bf16u*)(ws + WS_MIX), (const bf16u*)(ws + WS_WOUT) + (size_t)l * 1024 * 1024, MROWS, DM, DM}; pg8::OrderX S; S.init(128, DM, G, bid, 1);
            pg8::EpiResid<bf16u, bf16u> E{XSL, XSC, XSL, XSC, mod + 2048};
            pg8::gemm_phase<pg8::EpiResid<bf16u, bf16u>, pg8::OrderX, true, true>(ldsl, g, S, E, tid); } } SEAM(pb + 5);
        if (EN(8) && IN(pb + 6)) { for (int rep = 0; rep < NREP(8); ++rep) { FRESH(); LAYER_PTRS(); phase_norm<bf16u>(XSL, XSC, P.norm2_w + l * DM, mod, 3072, 4096, HN, skip, lane, wave, G, bid); } } SEAM(pb + 6);
        if (EN(9) && IN(pb + 7)) { for (int rep = 0; rep < NREP(9); ++rep) { FRESH(); LAYER_PTRS(); pg8::Gemm g{HN, (const bf16u*)(ws + WS_W13) + (size_t)l * 2 * DFF * 1024, MROWS, 2 * DFF, DM}; pg8::OrderX S; S.init(skip ? 128 : 130, 2 * DFF, G, bid, skip);
            pg8::EpiSwiGLU E{(bf16u*)(ws + WS_ACT)};
            pg8::gemm_phase<pg8::EpiSwiGLU, pg8::OrderX, true, true>(ldsl, g, S, E, tid);
            if (l == 0) { const int nwg = 130 * 22, R = (nwg + G - 1) / G, fi = nwg - (R - 1) * G;
                if (nwg % G == 0) prep_layer1_weights(P, lds, lane, wave, bid, G); else if (bid >= fi) prep_layer1_weights(P, lds, lane, wave, bid - fi, G - fi); } } } SEAM(pb + 7);
        if (EN(10) && IN(pb + 8)) { for (int rep = 0; rep < NREP(10); ++rep) { FRESH(); LAYER_PTRS(); if (l == 0) { ctx_gemm_resid<DFF, bf16u, bf16u>((const bf16u*)(ws + WS_ACT), (const bf16u*)(ws + WS_W2), XSC, XSC, mod + 5120 + 2 * NMODV, lds, tid, lane, wave, G, bid); __syncthreads(); }
            pg8::Gemm g{(const bf16u*)(ws + WS_ACT), (const bf16u*)(ws + WS_W2) + (size_t)l * 1024 * DFF, MROWS, DM, DFF}; pg8::OrderX S; S.init(128, DM, G, bid, 1);
            pg8::EpiResid<bf16u, float> E{XSL, XSC, P.out, P.out, mod + 5120};
            pg8::gemm_phase<pg8::EpiResid<bf16u, float>, pg8::OrderX, true, true>(ldsl, g, S, E, tid); } } SEAM(pb + 8);
        }
#undef IN
#undef SEAM
}

#ifndef MK_PER_PHASE
#define MK_PER_PHASE 0
#endif
extern "C" void kernel_launch(void* const* d_in, const int* in_sizes, int n_in, void* d_out, int out_size, void* d_ws, size_t ws_size, hipStream_t stream) {
    static int grid = 0;
    if (grid == 0) {
        if (n_in != 23 || in_sizes[0] != NBATCH * LSEQ * DM || out_size != NBATCH * LSEQ * DM || ws_size < WS_END) {
            fprintf(stderr, "kernel_launch: unexpected shapes (n_in %d, in0 %d, out %d, ws %zu)\n", n_in, n_in > 0 ? in_sizes[0] : -1, out_size, ws_size); grid = -1; return; }
        int dev = 0, cus = 0, per_cu = 0;
        (void)hipGetDevice(&dev); (void)hipDeviceGetAttribute(&cus, hipDeviceAttributeMultiprocessorCount, dev);
        if (hipFuncSetAttribute((const void*)hybrid_fwd, hipFuncAttributeMaxDynamicSharedMemorySize, LDS_BYTES) != hipSuccess) { fprintf(stderr, "kernel_launch: hipFuncSetAttribute failed\n"); grid = -1; return; }
        if (hipOccupancyMaxActiveBlocksPerMultiprocessor(&per_cu, (const void*)hybrid_fwd, 512, LDS_BYTES) != hipSuccess || per_cu < 1) { fprintf(stderr, "kernel_launch: occupancy query gives %d\n", per_cu); per_cu = 1; }
        (void)hipGetLastError();
        grid = cus * (per_cu > 1 ? 1 : per_cu);
        if (grid <= 0) grid = 256;
    }
    if (grid < 0) return;
    Params p{};
    const float** pp = (const float**)&p;
    for (int i = 0; i < 23; ++i) pp[i] = (const float*)d_in[i];
    p.out = (float*)d_out; p.ws = (unsigned char*)d_ws;
#if MK_PER_PHASE
    for (int ph = 0; ph < NPHASE; ++ph) { p.ph_lo = ph; p.ph_hi = ph + 1; hipLaunchKernelGGL(hybrid_fwd, dim3(grid), dim3(512), LDS_BYTES, stream, p); }
#else
    p.ph_lo = 0; p.ph_hi = NPHASE;
    void* args[] = {&p};
    hipError_t e = hipLaunchCooperativeKernel((const void*)hybrid_fwd, dim3(grid), dim3(512), args, LDS_BYTES, stream);
    if (e != hipSuccess) fprintf(stderr, "kernel_launch: cooperative launch failed: %s (grid %d)\n", hipGetErrorString(e), grid);
#endif
}
```

```cpp
#include <hip/hip_runtime.h>
#include <hip/hip_bf16.h>
#include <hip/hip_cooperative_groups.h>
#include <cstdio>
#include <cstdint>
namespace cg = cooperative_groups;


namespace pg8 {
#define PG8_LAS __attribute__((address_space(3)))
typedef unsigned short bf16_t;
typedef short bf16x8 __attribute__((ext_vector_type(8)));
typedef float f32x4 __attribute__((ext_vector_type(4)));
typedef unsigned u32x4 __attribute__((ext_vector_type(4)));
constexpr int BM = 256, BK = 64, HALF = 128, HTB = HALF * BK * 2  , STAGE_BYTES = 8 * HTB, NXCD = 8, WGM = 8;

__host__ __device__ __forceinline__ int lds_byte(int r, int c) { const int st = (r >> 4) * 2 + (c >> 5), rr = r & 15, cc = c & 31, ob = rr * 64 + cc * 2; return st * 1024 + (ob ^ (((ob >> 9) & 1) << 5)); }
__host__ __device__ __forceinline__ void stage_rc(int b, int& R, int& C) { const int st = b / 1024, sb = b % 1024, swz = sb ^ (((sb >> 9) & 1) << 5); R = (st >> 1) * 16 + swz / 64; C = (st & 1) * 32 + (swz % 64) / 2; }
__host__ __device__ __forceinline__ int perm32(int rho) { const int n = rho >> 4, i = rho & 15; return 8 * (i >> 2) + 4 * n + (i & 3); }

struct Unit { int pm, pn; };
struct Gemm { const bf16_t* A; const bf16_t* Bt; int M, N, K; };

struct StaticOrder {
    int nM, nN, nwg, G, c;
    __host__ __device__ void init(int M, int N, int G_, int c_) { nM = M / BM; nN = N / BM; nwg = nM * nN; G = G_; c = c_; }
    __host__ __device__ bool next(int i, Unit& u) const {
        const long L = (long)i * G + c; if (L >= nwg) return false;
        int wgid = (int)L; { const int q = nwg / NXCD, r = nwg % NXCD, xcd = wgid % NXCD, off = wgid / NXCD; wgid = (xcd < r ? xcd * (q + 1) : r * (q + 1) + (xcd - r) * q) + off; }
        const int nig = WGM * nN, gid = wgid / nig, fm = gid * WGM, gsz = (nM - fm) < WGM ? (nM - fm) : WGM;
        u.pm = fm + ((wgid % nig) % gsz); u.pn = (wgid % nig) / gsz; return true;
    }
    __device__ __forceinline__ void a_ready(const Unit&) const {}
    __device__ __forceinline__ void done(const Unit&) const {}
};
__device__ __forceinline__ unsigned cvt_pk_bf16(float lo, float hi) { unsigned r; asm volatile("v_cvt_pk_bf16_f32 %0, %1, %2" : "=v"(r) : "v"(lo), "v"(hi)); return r; }
typedef float f32x2 __attribute__((ext_vector_type(2)));
struct OrderX {
    StaticOrder b; int skip;
    __device__ void init(int ntm, int N, int G_, int c_, int skip_) { b.init(ntm * BM, N, G_, c_); skip = skip_; }
    __device__ bool next(int i, Unit& u) const { if (!b.next(i, u)) return false; if (skip) u.pm = u.pm + 1 + (u.pm >> 6); return true; }
    __device__ __forceinline__ void a_ready(const Unit&) const {}
    __device__ __forceinline__ void done(const Unit&) const {}
};
struct EpiInProj {
    static constexpr bool PERM = true, AFTER_DRAIN = false;
    bf16_t* U; float* DT;
    __device__ __forceinline__ void operator()(const f32x4 (&acc)[2][2][4][2], const Unit& u, int wr, int wc, int fr, int fq) const {
        const int row0 = u.pm * BM + wr * 64 + fr;
        if (u.pn < 8) {
            const int col0 = u.pn * BM + wc * 32 + 8 * fq;
#pragma unroll
            for (int ai = 0; ai < 2; ++ai)
#pragma unroll
                for (int m = 0; m < 4; ++m) { bf16_t* rowp = U + (size_t)(row0 + ai * HALF + m * 16) * 2048 + col0;
#pragma unroll
                    for (int bj = 0; bj < 2; ++bj) { const f32x4 v0 = acc[ai][bj][m][0], v1 = acc[ai][bj][m][1];
                        u32x4 w; w.x = cvt_pk_bf16(v0[0], v0[1]); w.y = cvt_pk_bf16(v0[2], v0[3]); w.z = cvt_pk_bf16(v1[0], v1[1]); w.w = cvt_pk_bf16(v1[2], v1[3]);
                        *(u32x4*)(rowp + bj * HALF) = w; } }
        } else if (wc == 0 && fq == 0) {
#pragma unroll
            for (int ai = 0; ai < 2; ++ai)
#pragma unroll
                for (int m = 0; m < 4; ++m) { float* p = DT + (size_t)(row0 + ai * HALF + m * 16) * 8;
                    *(f32x4*)p = acc[ai][0][m][0]; *(f32x4*)(p + 4) = acc[ai][0][m][1]; }
        }
    }
};
__device__ __forceinline__ f32x4 ld4(const float* p) { return *(const f32x4*)p; }
__device__ __forceinline__ f32x4 ld4(const bf16_t* p) { const unsigned long long r = *(const unsigned long long*)p; const unsigned lo = (unsigned)r, hi = (unsigned)(r >> 32);
    return (f32x4){__uint_as_float(lo << 16), __uint_as_float(lo & 0xffff0000u), __uint_as_float(hi << 16), __uint_as_float(hi & 0xffff0000u)}; }
__device__ __forceinline__ void st4(float* p, f32x4 v) { *(f32x4*)p = v; }
__device__ __forceinline__ void st4(bf16_t* p, f32x4 v) { const unsigned long long w = (unsigned long long)cvt_pk_bf16(v[0], v[1]) | ((unsigned long long)cvt_pk_bf16(v[2], v[3]) << 32); *(unsigned long long*)p = w; }
__device__ __forceinline__ void ld8(const float* p, f32x4& a, f32x4& b) { a = *(const f32x4*)p; b = *(const f32x4*)(p + 4); }
__device__ __forceinline__ void ld8(const bf16_t* p, f32x4& a, f32x4& b) { const u32x4 r = *(const u32x4*)p;
    a = (f32x4){__uint_as_float(r.x << 16), __uint_as_float(r.x & 0xffff0000u), __uint_as_float(r.y << 16), __uint_as_float(r.y & 0xffff0000u)};
    b = (f32x4){__uint_as_float(r.z << 16), __uint_as_float(r.z & 0xffff0000u), __uint_as_float(r.w << 16), __uint_as_float(r.w & 0xffff0000u)}; }
__device__ __forceinline__ void st8(float* p, f32x4 a, f32x4 b) { *(f32x4*)p = a; *(f32x4*)(p + 4) = b; }
__device__ __forceinline__ void st8(bf16_t* p, f32x4 a, f32x4 b) { u32x4 w; w.x = cvt_pk_bf16(a[0], a[1]); w.y = cvt_pk_bf16(a[2], a[3]); w.z = cvt_pk_bf16(b[0], b[1]); w.w = cvt_pk_bf16(b[2], b[3]); *(u32x4*)p = w; }
template <class RT, class OT> struct EpiResid {
    static constexpr bool PERM = true, AFTER_DRAIN = false;
    const RT* res_lat; const RT* res_ctx; OT* out_lat; OT* out_ctx; const float* gate;
    __device__ __forceinline__ void operator()(const f32x4 (&acc)[2][2][4][2], const Unit& u, int wr, int wc, int fr, int fq) const {
        const int b = u.pm / 65, w = u.pm % 65;
        const RT* rb; OT* ob; const float* gp;
        if (w == 0) { rb = res_ctx + (size_t)b * 256 * 1024; ob = out_ctx + (size_t)b * 256 * 1024; gp = gate + 2 * 6144; }
        else { const size_t o = ((size_t)b * 16384 + (size_t)(w - 1) * 256) * 1024; rb = res_lat + o; ob = out_lat + o; gp = gate + b * 6144; }
        const int col0 = u.pn * BM + wc * 32 + 8 * fq;
        f32x4 gv[2][2];
#pragma unroll
        for (int bj = 0; bj < 2; ++bj)
#pragma unroll
            for (int n = 0; n < 2; ++n) gv[bj][n] = *(const f32x4*)(gp + col0 + bj * HALF + 4 * n);
#pragma unroll
        for (int ai = 0; ai < 2; ++ai)
#pragma unroll
            for (int m = 0; m < 4; ++m) { const size_t ro = (size_t)(wr * 64 + fr + ai * HALF + m * 16) * 1024 + col0;
#pragma unroll
                for (int bj = 0; bj < 2; ++bj) {
                    f32x4 r0, r1; ld8(rb + ro + bj * HALF, r0, r1);
                    st8(ob + ro + bj * HALF, r0 + gv[bj][0] * acc[ai][bj][m][0], r1 + gv[bj][1] * acc[ai][bj][m][1]); } }
    }
};
struct EpiSwiGLU {
    static constexpr bool PERM = true, AFTER_DRAIN = false;
    bf16_t* ACT;
    __device__ __forceinline__ static float sw(float g, float u) { return g * u * __builtin_amdgcn_rcpf(1.0f + __builtin_amdgcn_exp2f(-1.4426950408889634f * g)); }
    __device__ __forceinline__ void operator()(const f32x4 (&acc)[2][2][4][2], const Unit& u, int wr, int wc, int fr, int fq) const {
        const int row0 = u.pm * BM + wr * 64 + fr, col0 = u.pn * HALF + wc * 32 + 8 * fq;
#pragma unroll
        for (int ai = 0; ai < 2; ++ai)
#pragma unroll
            for (int m = 0; m < 4; ++m) { const f32x4 g0 = acc[ai][0][m][0], g1 = acc[ai][0][m][1], u0 = acc[ai][1][m][0], u1 = acc[ai][1][m][1];
                u32x4 w; w.x = cvt_pk_bf16(sw(g0[0], u0[0]), sw(g0[1], u0[1])); w.y = cvt_pk_bf16(sw(g0[2], u0[2]), sw(g0[3], u0[3]));
                w.z = cvt_pk_bf16(sw(g1[0], u1[0]), sw(g1[1], u1[1])); w.w = cvt_pk_bf16(sw(g1[2], u1[2]), sw(g1[3], u1[3]));
                *(u32x4*)(ACT + (size_t)(row0 + ai * HALF + m * 16) * 2816 + col0) = w; }
    }
};
template <class Epi, class Sched, bool ALIGN_EPI = false, bool SP2 = false>
__device__ __forceinline__ void gemm_phase(PG8_LAS unsigned char* lds, const Gemm g, const Sched& S, const Epi& E, const int tid) {
    const int wid = __builtin_amdgcn_readfirstlane(tid >> 6), lane = tid & 63, wr = wid >> 2, wc = wid & 3, fr = lane & 15, fq = lane >> 4;
    const int K = g.K, nt = K / BK;
    unsigned voffA[2], voffB[2];
#pragma unroll
    for (int i = 0; i < 2; ++i) { int R, C; stage_rc(tid * 16 + i * 8192, R, C); const int Rb = Epi::PERM ? ((R & ~31) + perm32(R & 31)) : R;
        voffA[i] = (unsigned)(R * K + C) * 2u; voffB[i] = (unsigned)(Rb * K + C) * 2u; }
    const size_t kstep = (size_t)(BK * 2);
    const size_t hstep = (size_t)HALF * K * 2;
    const size_t tstep = 2 * hstep;
    const unsigned ldsw = (unsigned)wid * 1024u;
    const int aoff = lds_byte(wr * 64 + fr, fq * 8), boff = lds_byte(wc * 32 + fr, fq * 8);
#define PG8_SA(b, h) (((b) * 2 + (h)) * HTB)
#define PG8_SB(b, h) ((4 + (b) * 2 + (h)) * HTB)
#define PG8_STAGE(bufoff, gbase, voff) do { _Pragma("unroll") for (int _i = 0; _i < 2; ++_i) \
        __builtin_amdgcn_global_load_lds((const unsigned*)((const char*)(gbase) + (voff)[_i]), (PG8_LAS unsigned*)(lds + (bufoff) + ldsw + _i * 8192), 16, 0, 0); } while (0)
#define PG8_LDA(dst, b, h) do { _Pragma("unroll") for (int m = 0; m < 4; ++m) _Pragma("unroll") for (int k = 0; k < 2; ++k) dst[m][k] = *(const PG8_LAS bf16x8*)(lds + PG8_SA(b, h) + aoff + m * 2048 + k * 1024); } while (0)
#define PG8_LDB(dst, b, h) do { _Pragma("unroll") for (int n = 0; n < 2; ++n) _Pragma("unroll") for (int k = 0; k < 2; ++k) dst[n][k] = *(const PG8_LAS bf16x8*)(lds + PG8_SB(b, h) + boff + n * 2048 + k * 1024); } while (0)
#define PG8_MMA(ai, bj, At, Bt) do { __builtin_amdgcn_s_setprio(1); _Pragma("unroll") for (int m = 0; m < 4; ++m) _Pragma("unroll") for (int n = 0; n < 2; ++n) _Pragma("unroll") for (int k = 0; k < 2; ++k) \
        acc[ai][bj][m][n] = __builtin_amdgcn_mfma_f32_16x16x32_bf16(Bt[n][k], At[m][k], acc[ai][bj][m][n], 0, 0, 0); __builtin_amdgcn_s_setprio(0); } while (0)
#define PG8_WAIT_V(n) asm volatile("s_waitcnt vmcnt(" #n ")" ::: "memory")
#define PG8_WAIT_L(n) asm volatile("s_waitcnt lgkmcnt(" #n ")" ::: "memory")
#define PG8_BAR __builtin_amdgcn_s_barrier()
#define PG8_SCHED __builtin_amdgcn_sched_barrier(0)
    Unit cur, nxt; int ui = 0;
    if (!S.next(0, cur)) return;
    f32x4 acc[2][2][4][2];
#pragma unroll
    for (int a = 0; a < 2; ++a)
#pragma unroll
        for (int b = 0; b < 2; ++b)
#pragma unroll
            for (int m = 0; m < 4; ++m)
#pragma unroll
                for (int n = 0; n < 2; ++n) acc[a][b][m][n] = (f32x4){0.f, 0.f, 0.f, 0.f};
    bf16x8 At[4][2], B0[2][2], B1[2][2];
    const char* cA = (const char*)g.A + (size_t)cur.pm * tstep; const char* cB = (const char*)g.Bt + (size_t)cur.pn * tstep;
    S.a_ready(cur);
    if constexpr (SP2) {
        PG8_STAGE(PG8_SB(0, 0), cB, voffB); PG8_STAGE(PG8_SB(0, 1), cB + hstep, voffB); PG8_STAGE(PG8_SA(0, 0), cA, voffA); PG8_STAGE(PG8_SA(0, 1), cA + hstep, voffA);
        if (wr == 1) PG8_BAR;
        PG8_WAIT_V(2); PG8_BAR;
        PG8_STAGE(PG8_SB(1, 0), cB + kstep, voffB); PG8_STAGE(PG8_SA(1, 0), cA + kstep, voffA); PG8_STAGE(PG8_SB(1, 1), cB + hstep + kstep, voffB);
        PG8_WAIT_V(6); PG8_BAR;
    } else {
        PG8_STAGE(PG8_SB(0, 0), cB, voffB); PG8_STAGE(PG8_SA(0, 0), cA, voffA); PG8_STAGE(PG8_SB(0, 1), cB + hstep, voffB); PG8_STAGE(PG8_SA(0, 1), cA + hstep, voffA);
        if (wr == 1) PG8_BAR;
        PG8_WAIT_V(4); PG8_BAR;
        PG8_STAGE(PG8_SB(1, 0), cB + kstep, voffB); PG8_STAGE(PG8_SA(1, 0), cA + kstep, voffA); PG8_STAGE(PG8_SB(1, 1), cB + hstep + kstep, voffB);
        PG8_WAIT_V(6); PG8_BAR;
    }
    for (;;) {
        const bool has_next = S.next(ui + 1, nxt);
        const char* nA = has_next ? (const char*)g.A + (size_t)nxt.pm * tstep : cA; const char* nB = has_next ? (const char*)g.Bt + (size_t)nxt.pn * tstep : cB;
        for (int t = 0; t < nt; t += 2) {
            const bool last = (t == nt - 2);
            const char* a1 = cA + (size_t)(t + 1) * kstep;
            const char* a2 = last ? nA : cA + (size_t)(t + 2) * kstep; const char* b2 = last ? nB : cB + (size_t)(t + 2) * kstep;
            const char* a3 = a2 + kstep; const char* b3 = b2 + kstep;
            if (last && has_next) S.a_ready(nxt);
            if constexpr (SP2) {
            PG8_LDB(B0, 0, 0); PG8_LDB(B1, 0, 1); PG8_SCHED; PG8_LDA(At, 0, 0); PG8_STAGE(PG8_SA(1, 1), a1 + hstep, voffA);
            PG8_WAIT_V(8); PG8_WAIT_L(0); PG8_BAR; PG8_MMA(0, 0, At, B0); PG8_MMA(0, 1, At, B1); PG8_BAR; PG8_SCHED;
            PG8_LDA(At, 0, 1); PG8_STAGE(PG8_SB(0, 0), b2, voffB); PG8_STAGE(PG8_SB(0, 1), b2 + hstep, voffB); PG8_STAGE(PG8_SA(0, 0), a2, voffA);
            PG8_WAIT_V(8); PG8_WAIT_L(0); PG8_BAR; PG8_MMA(1, 0, At, B0); PG8_MMA(1, 1, At, B1); PG8_BAR; PG8_SCHED;
            PG8_LDB(B0, 1, 0); PG8_LDB(B1, 1, 1); PG8_SCHED; PG8_LDA(At, 1, 0); PG8_STAGE(PG8_SA(0, 1), a2 + hstep, voffA);
            PG8_WAIT_V(8); PG8_WAIT_L(0); PG8_BAR; PG8_MMA(0, 0, At, B0); PG8_MMA(0, 1, At, B1); PG8_BAR; PG8_SCHED;
            PG8_LDA(At, 1, 1); PG8_STAGE(PG8_SB(1, 0), b3, voffB); PG8_STAGE(PG8_SB(1, 1), b3 + hstep, voffB); PG8_STAGE(PG8_SA(1, 0), a3, voffA);
            PG8_WAIT_V(8); PG8_WAIT_L(0); PG8_BAR; PG8_MMA(1, 0, At, B0); PG8_MMA(1, 1, At, B1); PG8_BAR; PG8_SCHED;
            } else {
            PG8_LDB(B0, 0, 0); PG8_SCHED; PG8_LDA(At, 0, 0); PG8_STAGE(PG8_SA(1, 1), a1 + hstep, voffA);
            PG8_WAIT_L(8); PG8_BAR; PG8_WAIT_L(0); PG8_MMA(0, 0, At, B0); PG8_BAR; PG8_SCHED;
            PG8_LDB(B1, 0, 1); PG8_STAGE(PG8_SB(0, 0), b2, voffB);
            PG8_BAR; PG8_WAIT_L(0); PG8_MMA(0, 1, At, B1); PG8_BAR;
            PG8_LDA(At, 0, 1); PG8_STAGE(PG8_SA(0, 0), a2, voffA);
            PG8_BAR; PG8_WAIT_L(0); PG8_MMA(1, 0, At, B0); PG8_BAR; PG8_SCHED;
            PG8_STAGE(PG8_SB(0, 1), b2 + hstep, voffB);
            PG8_WAIT_V(6); PG8_BAR; PG8_MMA(1, 1, At, B1); PG8_BAR;
            PG8_LDB(B0, 1, 0); PG8_SCHED; PG8_LDA(At, 1, 0); PG8_STAGE(PG8_SA(0, 1), a2 + hstep, voffA);
            PG8_WAIT_L(8); PG8_BAR; PG8_WAIT_L(0); PG8_MMA(0, 0, At, B0); PG8_BAR; PG8_SCHED;
            PG8_LDB(B1, 1, 1); PG8_STAGE(PG8_SB(1, 0), b3, voffB);
            PG8_BAR; PG8_WAIT_L(0); PG8_MMA(0, 1, At, B1); PG8_BAR;
            PG8_LDA(At, 1, 1); PG8_STAGE(PG8_SA(1, 0), a3, voffA);
            PG8_BAR; PG8_WAIT_L(0); PG8_MMA(1, 0, At, B0); PG8_BAR; PG8_SCHED;
            PG8_STAGE(PG8_SB(1, 1), b3 + hstep, voffB);
            PG8_WAIT_V(6); PG8_BAR; PG8_MMA(1, 1, At, B1); PG8_BAR;
            }
        }
        if constexpr (ALIGN_EPI) { if (wr == 0) PG8_BAR; }
        if constexpr (!Epi::AFTER_DRAIN) { E(acc, cur, wr, wc, fr, fq); S.done(cur); }
        if (!has_next) break;
#pragma unroll
        for (int a = 0; a < 2; ++a)
#pragma unroll
            for (int b = 0; b < 2; ++b)
#pragma unroll
                for (int m = 0; m < 4; ++m)
#pragma unroll
                    for (int n = 0; n < 2; ++n) acc[a][b][m][n] = (f32x4){0.f, 0.f, 0.f, 0.f};
        cur = nxt; cA = nA; cB = nB; ++ui;
        if constexpr (ALIGN_EPI) { if (wr == 1) PG8_BAR; }
    }
    PG8_WAIT_V(0);
    if constexpr (!ALIGN_EPI) { if (wr == 0) PG8_BAR; }
    PG8_BAR;
    if constexpr (Epi::AFTER_DRAIN) { E.fused(acc, cur, wr, wc, fr, fq, lds, wid, lane); S.done(cur); }
#undef PG8_SA
#undef PG8_SB
#undef PG8_STAGE
#undef PG8_LDA
#undef PG8_LDB
#undef PG8_MMA
#undef PG8_WAIT_V
#undef PG8_WAIT_L
#undef PG8_BAR
#undef PG8_SCHED
}
}
namespace att {
using bf16 = __hip_bfloat16;
constexpr int   D = 128, NW = 8, QBLK = 32, KVBLK = 64;
constexpr float SCALE = 0.088388347648318440f;
constexpr float THR = 8.f;
constexpr int SDEPTH = 2;
constexpr int LDQ = 2048, LDK = 2048, LDO = 1024;
constexpr size_t SHM_V = KVBLK * D * 2, SHM_K = KVBLK * D * 2, SHM_ATTN = 2 * SHM_V + 2 * SHM_K + NW * 64 * 4;
using bf16x8 = __attribute__((ext_vector_type(8))) short;
using s16x4  = __attribute__((ext_vector_type(4))) short;
using f32x16 = __attribute__((ext_vector_type(16))) float;
using f32x8  = __attribute__((ext_vector_type(8))) float;
using u32x4  = __attribute__((ext_vector_type(4))) unsigned;
#define KSWZ(row, colB) ((row) * 256 + ((colB) ^ (((row) & 7) << 4)))
#define SBAR() __builtin_amdgcn_sched_barrier(0)
__device__ __forceinline__ int crow(int r, int hi) { return (r & 3) + 8 * (r >> 2) + 4 * hi; }
__device__ __forceinline__ unsigned cvtpk(float lo, float hi) {
  unsigned r; asm volatile("v_cvt_pk_bf16_f32 %0, %1, %2" : "=v"(r) : "v"(lo), "v"(hi)); return r;
}
template <typename TIn> struct Stage;
template <> struct Stage<bf16>  { using T = bf16x8;
  __device__ static __forceinline__ T ld8(const bf16* p) { return *reinterpret_cast<const bf16x8*>(p); }
  __device__ static __forceinline__ bf16x8 tobf(T x) { return x; } };
template <> struct Stage<float> { using T = f32x8;
  __device__ static __forceinline__ T ld8(const float* p) { return *reinterpret_cast<const f32x8*>(p); }
  __device__ static __forceinline__ bf16x8 tobf(T x) {
    u32x4 w = {cvtpk(x[0], x[1]), cvtpk(x[2], x[3]), cvtpk(x[4], x[5]), cvtpk(x[6], x[7])}; return *reinterpret_cast<bf16x8*>(&w); } };

template <bool FIXED>
__device__ __forceinline__ void partialSM(f32x16& p0, f32x16& p1, float& m_reg, float& mn, float& alpha) {
  if constexpr (FIXED) { mn = 0.f; alpha = 1.f; }
  else {
    float pmax = p0[0]; for (int r = 1; r < 16; ++r) pmax = fmaxf(pmax, p0[r]); for (int r = 0; r < 16; ++r) pmax = fmaxf(pmax, p1[r]);
    { auto rr = __builtin_amdgcn_permlane32_swap(__float_as_uint(pmax), __float_as_uint(pmax), false, false);
      pmax = fmaxf(__uint_as_float(rr[0]), __uint_as_float(rr[1])); }
    if (__builtin_expect(__all(pmax - m_reg <= THR), 1)) { mn = m_reg; alpha = 1.f; }
    else { mn = fmaxf(m_reg, pmax); alpha = __builtin_amdgcn_exp2f(m_reg - mn); m_reg = mn; }
    for (int r = 0; r < 16; ++r) p0[r] -= mn; for (int r = 0; r < 16; ++r) p1[r] -= mn;
  }
  for (int r = 0; r < 16; ++r) p0[r] = __builtin_amdgcn_exp2f(p0[r]);
}
__device__ __forceinline__ void finishSM(f32x16& p0, f32x16& p1, float alpha, float& l_reg, bf16x8& pa0, bf16x8& pa1, bf16x8& pa2, bf16x8& pa3) {
  for (int r = 0; r < 16; ++r) p1[r] = __builtin_amdgcn_exp2f(p1[r]);
  float ps = 0; for (int r = 0; r < 16; ++r) ps += p0[r]; for (int r = 0; r < 16; ++r) ps += p1[r];
  asm volatile("" : "+v"(ps));
  l_reg = l_reg * alpha + ps;
#define PK4(P, BASE, OUT) do { u32x4 w = {cvtpk(P[BASE + 0], P[BASE + 1]), cvtpk(P[BASE + 2], P[BASE + 3]), cvtpk(P[BASE + 4], P[BASE + 5]), cvtpk(P[BASE + 6], P[BASE + 7])}; \
    OUT = *reinterpret_cast<bf16x8*>(&w); } while (0)
  PK4(p0, 0, pa0); PK4(p0, 8, pa1); PK4(p1, 0, pa2); PK4(p1, 8, pa3);
#undef PK4
}
__device__ __forceinline__ void qkt(f32x16& p0, f32x16& p1, const bf16* Ks, const bf16x8* qr, int r32, int hi) {
  p0 = f32x16{}; p1 = f32x16{};
  for (int d0 = 0; d0 < 8; ++d0) { int cb = (d0 * 16 + hi * 8) * 2;
    bf16x8 b0 = *reinterpret_cast<const bf16x8*>((const char*)Ks + KSWZ(r32, cb));
    bf16x8 b1 = *reinterpret_cast<const bf16x8*>((const char*)Ks + KSWZ(32 + r32, cb));
    p0 = __builtin_amdgcn_mfma_f32_32x32x16_bf16(b0, qr[d0], p0, 0, 0, 0);
    p1 = __builtin_amdgcn_mfma_f32_32x32x16_bf16(b1, qr[d0], p1, 0, 0, 0); }
}
__device__ __forceinline__ int v_st(int k, int c) { const int kk = k;
  return ((kk >> 3) * 4 + (c >> 5)) * 512 + ((kk & 7) * 32 + (c & 31)) * 2; }
__device__ __forceinline__ int v_rd_base(int lane) { return ((lane & 3) << 3) | (((lane >> 2) & 3) << 6) | (((lane >> 4) & 1) << 5) | (((lane >> 5) & 1) << 8); }
constexpr int v_rd_off(int d0, int ks, int half) { return d0 * 512 + ks * 4096 + half * 2048; }
template <int OFF> __device__ __forceinline__ s16x4 tr_read(int vb) {
  s16x4 r; asm volatile("ds_read_b64_tr_b16 %0, %1 offset:%2" : "=&v"(r) : "v"(vb), "i"(OFF) : "memory"); return r;
}
template <int D0> __device__ __forceinline__ void pv_one(f32x16& od, int vb, bf16x8 pa0, bf16x8 pa1, bf16x8 pa2, bf16x8 pa3) {
  const s16x4 l0 = tr_read<v_rd_off(D0, 0, 0)>(vb), h0 = tr_read<v_rd_off(D0, 0, 1)>(vb), l1 = tr_read<v_rd_off(D0, 1, 0)>(vb), h1 = tr_read<v_rd_off(D0, 1, 1)>(vb);
  const s16x4 l2 = tr_read<v_rd_off(D0, 2, 0)>(vb), h2 = tr_read<v_rd_off(D0, 2, 1)>(vb), l3 = tr_read<v_rd_off(D0, 3, 0)>(vb), h3 = tr_read<v_rd_off(D0, 3, 1)>(vb);
  asm volatile("s_waitcnt lgkmcnt(0)" ::: "memory"); SBAR();
#define PK(L, H) (bf16x8){L[0], L[1], L[2], L[3], H[0], H[1], H[2], H[3]}
  od = __builtin_amdgcn_mfma_f32_32x32x16_bf16(pa0, PK(l0, h0), od, 0, 0, 0);
  od = __builtin_amdgcn_mfma_f32_32x32x16_bf16(pa1, PK(l1, h1), od, 0, 0, 0);
  od = __builtin_amdgcn_mfma_f32_32x32x16_bf16(pa2, PK(l2, h2), od, 0, 0, 0);
  od = __builtin_amdgcn_mfma_f32_32x32x16_bf16(pa3, PK(l3, h3), od, 0, 0, 0);
#undef PK
}
__device__ __forceinline__ void pv_d0(f32x16* o, int vb, bf16x8 pa0, bf16x8 pa1, bf16x8 pa2, bf16x8 pa3) {
  pv_one<0>(o[0], vb, pa0, pa1, pa2, pa3); pv_one<1>(o[1], vb, pa0, pa1, pa2, pa3); pv_one<2>(o[2], vb, pa0, pa1, pa2, pa3); pv_one<3>(o[3], vb, pa0, pa1, pa2, pa3);
}

__device__ __forceinline__ void load_q_normed(const bf16* Qw, const float* qnw, const float2* rope, int trow, int hi, bf16x8* qr) {
  constexpr float C = SCALE * 1.4426950408889634f;
  float v[8][8]; float ss = 0.f;
#pragma unroll
  for (int d0 = 0; d0 < 8; ++d0) { const u32x4 raw = *reinterpret_cast<const u32x4*>(Qw + d0 * 16);
    v[d0][0] = __uint_as_float(raw.x << 16); v[d0][1] = __uint_as_float(raw.x & 0xffff0000u); v[d0][2] = __uint_as_float(raw.y << 16); v[d0][3] = __uint_as_float(raw.y & 0xffff0000u);
    v[d0][4] = __uint_as_float(raw.z << 16); v[d0][5] = __uint_as_float(raw.z & 0xffff0000u); v[d0][6] = __uint_as_float(raw.w << 16); v[d0][7] = __uint_as_float(raw.w & 0xffff0000u);
#pragma unroll
    for (int j = 0; j < 8; ++j) ss += v[d0][j] * v[d0][j]; }
  { auto rr = __builtin_amdgcn_permlane32_swap(__float_as_uint(ss), __float_as_uint(ss), false, false); ss = __uint_as_float(rr[0]) + __uint_as_float(rr[1]); }
  const float rstd = rsqrtf(ss * (1.0f / 128.0f) + 1e-6f);
#pragma unroll
  for (int d0 = 0; d0 < 8; ++d0) { const float* wp = qnw + d0 * 16 + hi * 8;
#pragma unroll
    for (int j = 0; j < 8; ++j) v[d0][j] = (v[d0][j] * rstd) * (wp[j] * C); }
  if (trow >= 0) {
#pragma unroll
    for (int ax = 0; ax < 2; ++ax) { const float2* rp = rope + (ax ? (trow & 63) : (trow >> 6)) * 32 + hi * 8;
#pragma unroll
      for (int b = 0; b < 2; ++b)
#pragma unroll
        for (int j = 0; j < 8; ++j) { const float2 cs = rp[16 * b + j]; const float x1 = v[4 * ax + b][j], x2 = v[4 * ax + b + 2][j];
          v[4 * ax + b][j] = x1 * cs.x - x2 * cs.y; v[4 * ax + b + 2][j] = x2 * cs.x + x1 * cs.y; } } }
#pragma unroll
  for (int d0 = 0; d0 < 8; ++d0) { u32x4 w = {cvtpk(v[d0][0], v[d0][1]), cvtpk(v[d0][2], v[d0][3]), cvtpk(v[d0][4], v[d0][5]), cvtpk(v[d0][6], v[d0][7])}; qr[d0] = *reinterpret_cast<bf16x8*>(&w); }
}
template <typename TQ, bool FIXED>
__device__ __forceinline__ void attn_dense_body(const TQ* __restrict__ Qb, const bf16* __restrict__ Kh, const bf16* __restrict__ Vh,
                                                bf16* __restrict__ Ob, int seq, char* lds, const int tid, const float* qnw, const float2* rope, const int t0) {
  using St = Stage<bf16>; using SQ = Stage<TQ>;
  const int wid = tid >> 6, lane = tid & 63, r32 = lane & 31, hi = lane >> 5;
  bf16* V_lds = (bf16*)lds; bf16* K_lds = (bf16*)(lds + 2 * SHM_V);
  float* ws = (float*)(lds + 2 * SHM_V + 2 * SHM_K) + wid * 64; float* li_l = ws; float* al_l = ws + 32;
  float m_reg = FIXED ? 0.f : -1e30f, l_reg = 0; f32x16 o[4] = {}; bf16x8 qr[8];
  const TQ* Qw = Qb + (long)(wid * QBLK + r32) * LDQ + hi * 8;
  load_q_normed(Qw, qnw, rope, t0 < 0 ? -1 : t0 + wid * QBLK + r32, hi, qr);
  const int sr = tid >> 4, sc = (tid & 15) * 8, vst0 = v_st(sr, sc), vst1 = v_st(32 + sr, sc);
  const int vb0 = (int)(uintptr_t)V_lds + v_rd_base(lane);
  struct { typename St::T vs0, vs1, ks0, ks1; } sr_[SDEPTH];
#define SLOAD(i, k0) do { sr_[i].vs0 = St::ld8(&Vh[(long)((k0) + sr) * LDK + sc]); sr_[i].vs1 = St::ld8(&Vh[(long)((k0) + 32 + sr) * LDK + sc]); \
    sr_[i].ks0 = St::ld8(&Kh[(long)((k0) + sr) * LDK + sc]); sr_[i].ks1 = St::ld8(&Kh[(long)((k0) + 32 + sr) * LDK + sc]); } while (0)
#define SWRITE(b, i) do { *(bf16x8*)((char*)V_lds + (b) * SHM_V + vst0) = St::tobf(sr_[i].vs0);          \
    *(bf16x8*)((char*)V_lds + (b) * SHM_V + vst1) = St::tobf(sr_[i].vs1); int kc = sc * 2;               \
    *(bf16x8*)((char*)K_lds + (b) * SHM_K + KSWZ(sr, kc)) = St::tobf(sr_[i].ks0);                       \
    *(bf16x8*)((char*)K_lds + (b) * SHM_K + KSWZ(32 + sr, kc)) = St::tobf(sr_[i].ks1); } while (0)
#define SWAIT() do { if constexpr (SDEPTH == 2) asm volatile("s_waitcnt vmcnt(4)" ::: "memory"); else asm volatile("s_waitcnt vmcnt(0)" ::: "memory"); } while (0)
#define RESC(a) do { if (__any((a) < 1.f)) { if (hi == 0) al_l[r32] = (a); asm volatile("s_waitcnt lgkmcnt(0)" ::: "memory"); \
    for (int d = 0; d < 4; ++d) for (int r = 0; r < 16; ++r) o[d][r] *= al_l[crow(r, hi)]; } } while (0)
  f32x16 pA0, pA1, pB0, pB1; float mnA, mnB, alA, alB; bf16x8 pa0, pa1, pa2, pa3; const int NT = seq / KVBLK;
  constexpr int SE = 0, SO = SDEPTH - 1;
  SLOAD(SE, 0); asm volatile("s_waitcnt vmcnt(0)" ::: "memory"); SWRITE(0, SE); __syncthreads();
  qkt(pA0, pA1, K_lds, qr, r32, hi); partialSM<FIXED>(pA0, pA1, m_reg, mnA, alA);
  SLOAD(SO, KVBLK); if constexpr (SDEPTH == 2) { if (2 < NT) SLOAD(SE, 2 * KVBLK); }
  SWAIT(); SWRITE(1, SO); __syncthreads();
  for (int j = 1; j + 1 < NT; j += 2) {
    SBAR(); qkt(pB0, pB1, (bf16*)((char*)K_lds + SHM_K), qr, r32, hi);
    finishSM(pA0, pA1, alA, l_reg, pa0, pa1, pa2, pa3); SBAR();
    SLOAD(SO, (j + SDEPTH) * KVBLK); SBAR();
    pv_d0(o, vb0, pa0, pa1, pa2, pa3); partialSM<FIXED>(pB0, pB1, m_reg, mnB, alB);
    __syncthreads(); SWAIT(); SWRITE(0, SE);
    RESC(alB); __syncthreads();
    SBAR(); qkt(pA0, pA1, K_lds, qr, r32, hi);
    finishSM(pB0, pB1, alB, l_reg, pa0, pa1, pa2, pa3); SBAR();
    if (SDEPTH == 1 || j + 3 < NT) SLOAD(SE, (j + 1 + SDEPTH) * KVBLK); SBAR();
    pv_d0(o, vb0 + (int)SHM_V, pa0, pa1, pa2, pa3); partialSM<FIXED>(pA0, pA1, m_reg, mnA, alA);
    __syncthreads(); SWAIT(); SWRITE(1, SO);
    RESC(alA); __syncthreads();
  }
  SBAR(); qkt(pB0, pB1, (bf16*)((char*)K_lds + SHM_K), qr, r32, hi);
  finishSM(pA0, pA1, alA, l_reg, pa0, pa1, pa2, pa3); SBAR();
  pv_d0(o, vb0, pa0, pa1, pa2, pa3); partialSM<FIXED>(pB0, pB1, m_reg, mnB, alB);
  __syncthreads(); RESC(alB);
  finishSM(pB0, pB1, alB, l_reg, pa0, pa1, pa2, pa3); SBAR();
  pv_d0(o, vb0 + (int)SHM_V, pa0, pa1, pa2, pa3);
  { auto rr = __builtin_amdgcn_permlane32_swap(__float_as_uint(l_reg), __float_as_uint(l_reg), false, false); l_reg = __uint_as_float(rr[0]) + __uint_as_float(rr[1]); }
  if (hi == 0) li_l[r32] = l_reg; asm volatile("s_waitcnt lgkmcnt(0)" ::: "memory");
  float rli[16];
#pragma unroll
  for (int r = 0; r < 16; ++r) rli[r] = __builtin_amdgcn_rcpf(li_l[crow(r, hi)]);
  bf16* Ow = Ob + (long)(wid * QBLK) * LDO;
#pragma unroll
  for (int r = 0; r < 16; ++r) { int orow = crow(r, hi);
    for (int d0 = 0; d0 < 4; ++d0) Ow[(long)orow * LDO + d0 * 32 + r32] = __float2bfloat16(o[d0][r] * rli[r]); }
#undef SLOAD
#undef SWRITE
#undef SWAIT
#undef RESC
}

constexpr size_t SHM_ATTN_DMA = 4 * SHM_V + 4 * SHM_K + NW * 64 * 4;
#define ATT_LAS __attribute__((address_space(3)))
template <typename TQ>
__device__ __forceinline__ void attn_dense_body_dma(const TQ* __restrict__ Qb, const bf16* __restrict__ Kh, const bf16* __restrict__ Vh,
                                                    bf16* __restrict__ Ob, int seq, char* lds, const int tid, const float* qnw, const float2* rope, const int t0) {
  using SQ = Stage<TQ>;
  const int wid = __builtin_amdgcn_readfirstlane(tid >> 6), lane = tid & 63, r32 = lane & 31, hi = lane >> 5;
  char* V_lds = lds; char* K_lds = lds + 4 * SHM_V;
  float* ws = (float*)(lds + 4 * SHM_V + 4 * SHM_K) + wid * 64; float* li_l = ws;
  float m_reg = 0.f, l_reg = 0; f32x16 o[4] = {}; bf16x8 qr[8];
  const TQ* Qw = Qb + (long)(wid * QBLK + r32) * LDQ + hi * 8;
  load_q_normed(Qw, qnw, rope, t0 < 0 ? -1 : t0 + wid * QBLK + r32, hi, qr);
  const int vb0 = (int)(uintptr_t)V_lds + v_rd_base(lane);
  int koff[2], voff[2];
#pragma unroll
  for (int i = 0; i < 2; ++i) { const int P = wid * 1024 + lane * 16 + i * 8192;
    { const int row = P >> 8, colB = (P & 255) ^ ((row & 7) << 4); koff[i] = row * LDK + (colB >> 1); }
    { const int sub = P >> 9, k = (sub >> 2) * 8 + ((lane & 31) >> 2), c = (sub & 3) * 32 + (lane & 3) * 8; voff[i] = k * LDK + c; } }
#define DMA_TILE(t, slot) do { const bf16* kb_ = Kh + (long)(t) * (KVBLK * LDK); const bf16* vb_ = Vh + (long)(t) * (KVBLK * LDK); \
    __builtin_amdgcn_global_load_lds((const unsigned*)(kb_ + koff[0]), (ATT_LAS unsigned*)(K_lds + (slot) * SHM_K + wid * 1024), 16, 0, 0); \
    __builtin_amdgcn_global_load_lds((const unsigned*)(kb_ + koff[1]), (ATT_LAS unsigned*)(K_lds + (slot) * SHM_K + 8192 + wid * 1024), 16, 0, 0); \
    __builtin_amdgcn_global_load_lds((const unsigned*)(vb_ + voff[0]), (ATT_LAS unsigned*)(V_lds + (slot) * SHM_V + wid * 1024), 16, 0, 0); \
    __builtin_amdgcn_global_load_lds((const unsigned*)(vb_ + voff[1]), (ATT_LAS unsigned*)(V_lds + (slot) * SHM_V + 8192 + wid * 1024), 16, 0, 0); } while (0)
#define PUBLISH(n) do { asm volatile("s_waitcnt vmcnt(" #n ")" ::: "memory"); asm volatile("s_waitcnt lgkmcnt(0)" ::: "memory"); __builtin_amdgcn_s_barrier(); SBAR(); } while (0)
  f32x16 pA0, pA1, pB0, pB1; float mnA, mnB, alA, alB; bf16x8 pa0, pa1, pa2, pa3; const int NT = seq / KVBLK;
  DMA_TILE(0, 0); DMA_TILE(1, 1);
  PUBLISH(4);
  qkt(pA0, pA1, (const bf16*)K_lds, qr, r32, hi); partialSM<true>(pA0, pA1, m_reg, mnA, alA);
  DMA_TILE(2, 2);
  PUBLISH(4);
  for (int j = 1; j + 1 < NT; j += 2) {
    SBAR(); qkt(pB0, pB1, (const bf16*)(K_lds + (j & 3) * (int)SHM_K), qr, r32, hi);
    finishSM(pA0, pA1, alA, l_reg, pa0, pa1, pa2, pa3); SBAR();
    DMA_TILE(j + 2, (j + 2) & 3); SBAR();
    pv_d0(o, vb0 + ((j - 1) & 3) * (int)SHM_V, pa0, pa1, pa2, pa3); partialSM<true>(pB0, pB1, m_reg, mnB, alB);
    PUBLISH(4);
    SBAR(); qkt(pA0, pA1, (const bf16*)(K_lds + ((j + 1) & 3) * (int)SHM_K), qr, r32, hi);
    finishSM(pB0, pB1, alB, l_reg, pa0, pa1, pa2, pa3); SBAR();
    if (j + 3 < NT) { DMA_TILE(j + 3, (j + 3) & 3); } SBAR();
    pv_d0(o, vb0 + (j & 3) * (int)SHM_V, pa0, pa1, pa2, pa3); partialSM<true>(pA0, pA1, m_reg, mnA, alA);
    if (j + 3 < NT) { PUBLISH(4); } else { PUBLISH(0); }
  }
  SBAR(); qkt(pB0, pB1, (const bf16*)(K_lds + ((NT - 1) & 3) * (int)SHM_K), qr, r32, hi);
  finishSM(pA0, pA1, alA, l_reg, pa0, pa1, pa2, pa3); SBAR();
  pv_d0(o, vb0 + ((NT - 2) & 3) * (int)SHM_V, pa0, pa1, pa2, pa3); partialSM<true>(pB0, pB1, m_reg, mnB, alB);
  finishSM(pB0, pB1, alB, l_reg, pa0, pa1, pa2, pa3); SBAR();
  pv_d0(o, vb0 + ((NT - 1) & 3) * (int)SHM_V, pa0, pa1, pa2, pa3);
  { auto rr = __builtin_amdgcn_permlane32_swap(__float_as_uint(l_reg), __float_as_uint(l_reg), false, false); l_reg = __uint_as_float(rr[0]) + __uint_as_float(rr[1]); }
  if (hi == 0) li_l[r32] = l_reg; asm volatile("s_waitcnt lgkmcnt(0)" ::: "memory");
  float rli[16];
#pragma unroll
  for (int r = 0; r < 16; ++r) rli[r] = __builtin_amdgcn_rcpf(li_l[crow(r, hi)]);
  bf16* Ow = Ob + (long)(wid * QBLK) * LDO;
#pragma unroll
  for (int r = 0; r < 16; ++r) { int orow = crow(r, hi);
    for (int d0 = 0; d0 < 4; ++d0) Ow[(long)orow * LDO + d0 * 32 + r32] = __float2bfloat16(o[d0][r] * rli[r]); }
  asm volatile("s_waitcnt vmcnt(0)" ::: "memory");
#undef DMA_TILE
#undef PUBLISH
}
}
constexpr int DM = 1024, LSEQ = 16384, CTXL = 256, NBATCH = 2, SEQU = LSEQ + CTXL, MROWS = NBATCH * SEQU;
constexpr int NU = 2048;
constexpr int NIN = 2304;
constexpr int DFF = 2816, NMODV = 6144;
constexpr int NCHUNK = MROWS / 128, CPB = SEQU / 128;
constexpr float EPSN = 1e-6f;
constexpr size_t MiB = 1u << 20;
constexpr size_t WS_WIN = 0, WS_WOUT = 9 * MiB, WS_W13 = 13 * MiB, WS_W2 = 35 * MiB, WS_MODP = 46 * MiB, WS_MOD = 48 * MiB, WS_ROPE = 49 * MiB, WS_DT = 50 * MiB, WS_CD = 52 * MiB;
constexpr size_t WS_BAR = 52 * MiB + 512 * 1024;
constexpr size_t WS_ST = 53 * MiB, WS_SP = 86 * MiB, WS_XBC = 103 * MiB, WS_HN = 53 * MiB  ;
constexpr size_t WS_XSL = 136 * MiB, WS_XSC = 264 * MiB, WS_U = 266 * MiB, WS_MIX = 396 * MiB, WS_ACT = 266 * MiB  , WS_END = 461 * MiB;
constexpr int LDS_TAB = 149504, LDS_BYTES = 149504 + 512;
constexpr int NPHASE = 20;

typedef unsigned short bf16u;
typedef short bf16x8 __attribute__((ext_vector_type(8)));
typedef short s16x4 __attribute__((ext_vector_type(4)));
typedef float f32x4 __attribute__((ext_vector_type(4)));
typedef unsigned u32x4 __attribute__((ext_vector_type(4)));
typedef unsigned u32x2 __attribute__((ext_vector_type(2)));
#define LDSW() asm volatile("s_waitcnt lgkmcnt(0)" ::: "memory")
__device__ __forceinline__ float bf2f(unsigned short h) { return __uint_as_float((unsigned)h << 16); }
__device__ __forceinline__ float bflo(unsigned w) { return __uint_as_float(w << 16); }
__device__ __forceinline__ float bfhi(unsigned w) { return __uint_as_float(w & 0xffff0000u); }
__device__ __forceinline__ unsigned pk2(float lo, float hi) { return pg8::cvt_pk_bf16(lo, hi); }
__device__ __forceinline__ unsigned short f2bf1(float f) { return (unsigned short)(pg8::cvt_pk_bf16(f, 0.f) & 0xffffu); }
__device__ __forceinline__ float bperm(float v, int srclane) { return __builtin_bit_cast(float, __builtin_amdgcn_ds_bpermute(srclane << 2, __builtin_bit_cast(int, v))); }
__device__ __forceinline__ float rdlane(float v, int l) { return __builtin_bit_cast(float, __builtin_amdgcn_readlane(__builtin_bit_cast(int, v), l)); }
__device__ __forceinline__ float wave_sum(float v, int lane) {
#pragma unroll
    for (int o = 1; o < 64; o <<= 1) v += bperm(v, lane ^ o);
    return v;
}
__device__ __forceinline__ float siluf(float x) { return x * __builtin_amdgcn_rcpf(1.0f + __builtin_amdgcn_exp2f(-1.4426950408889634f * x)); }
__device__ __forceinline__ float softplusf(float x) { return fmaxf(x, 0.f) + log1pf(__expf(-fabsf(x))); }

struct Params {
    const float *x, *c, *ctx, *c_ctx, *norm1_w, *norm2_w, *w_mod, *b_mod, *w_in, *pool_w, *pool_scale, *conv_w, *conv_b, *dt_bias, *a_log, *d_skip, *ssd_norm_w,
                *q_norm_w, *k_norm_w, *w_out, *w1, *w3, *w2;
    float* out; unsigned char* ws; int ph_lo, ph_hi;
};

__device__ __forceinline__ void transpose_tile(const float* W, int ldw, int scol0, bf16u* WT, int K, int n0, int k0, float* scr, int lane) {
    const int nn = lane & 31; const int sc = scol0 >= 0 ? scol0 + nn : ((scol0 == -2 && nn < 8) ? 1024 + nn : -1);
#pragma unroll 8
    for (int i = 0; i < 32; ++i) { const int kk = 2 * i + (lane >> 5); scr[kk * 33 + nn] = sc >= 0 ? W[(size_t)(k0 + kk) * ldw + sc] : 0.f; }
    LDSW();
    const int c = lane & 7;
#pragma unroll
    for (int j = 0; j < 4; ++j) { const int n = (lane >> 3) + 8 * j; const float* s = scr + (8 * c) * 33 + n;
        u32x4 o; o.x = pk2(s[0 * 33], s[1 * 33]); o.y = pk2(s[2 * 33], s[3 * 33]); o.z = pk2(s[4 * 33], s[5 * 33]); o.w = pk2(s[6 * 33], s[7 * 33]);
        *(u32x4*)(WT + (size_t)(n0 + n) * K + k0 + 8 * c) = o; }
    LDSW();
}
constexpr int PREP_I_IN = 16 * 72, PREP_I_OUT = 16 * 32, PREP_I_13 = 16 * 176, PREP_I_2 = 44 * 32, PREP_I_L = PREP_I_IN + PREP_I_OUT + PREP_I_13 + PREP_I_2;
__device__ __forceinline__ void prep_weight_item(const Params& P, int l, int r, float* scr, int lane) {
    if (r < PREP_I_IN) { const int kb = r / 72, nb = r % 72, n0 = 32 * nb; const int sc0 = n0 < 1024 ? n0 : (n0 < 2048 ? n0 + 8 : (n0 == 2048 ? -2 : -1));
        transpose_tile(P.w_in + (size_t)l * 1024 * 2056, 2056, sc0, (bf16u*)(P.ws + WS_WIN) + (size_t)l * NIN * 1024, 1024, n0, 64 * kb, scr, lane); return; }
    r -= PREP_I_IN;
    if (r < PREP_I_OUT) { const int kb = r / 32, nb = r % 32;
        transpose_tile(P.w_out + (size_t)l * 1024 * 1024, 1024, 32 * nb, (bf16u*)(P.ws + WS_WOUT) + (size_t)l * 1024 * 1024, 1024, 32 * nb, 64 * kb, scr, lane); return; }
    r -= PREP_I_OUT;
    if (r < PREP_I_13) { const int kb = r / 176, nb = r % 176, n0 = 32 * nb, pn = n0 >> 8, s = (n0 >> 7) & 1, i0 = n0 & 127;
        transpose_tile((s ? P.w3 : P.w1) + (size_t)l * 1024 * DFF, DFF, 128 * pn + i0, (bf16u*)(P.ws + WS_W13) + (size_t)l * 2 * DFF * 1024, 1024, n0, 64 * kb, scr, lane); return; }
    r -= PREP_I_13;
    { const int kb = r / 32, nb = r % 32;
        transpose_tile(P.w2 + (size_t)l * DFF * 1024, 1024, 32 * nb, (bf16u*)(P.ws + WS_W2) + (size_t)l * 1024 * DFF, DFF, 32 * nb, 64 * kb, scr, lane); }
}
__device__ __forceinline__ void prep_layer1_weights(const Params& P, unsigned char* lds, int lane, int wave, int vb, int nvb) {
    float* scr = (float*)(lds + wave * 8448);
    for (int r = vb * 8 + wave; r < PREP_I_L; r += nvb * 8) prep_weight_item(P, 1, r, scr, lane);
}
__device__ __forceinline__ void phase_prep(const Params& P, unsigned char* lds, int tid, int lane, int wave, int G, const int bid) {
    float* SC = (float*)(lds + 8 * 8448);
    for (int i = tid; i < 3072; i += 512) { const int wh = i >> 10, k = i & 1023; const float v = wh < 2 ? P.c[wh * 1024 + k] : P.c_ctx[k]; SC[i] = siluf(v); }
    __syncthreads();
    float* scr = (float*)(lds + wave * 8448);
    const int gw = bid * 8 + wave, NGW = G * 8;
    constexpr int I_IN = 16 * 72, I_OUT = 16 * 32, I_13 = 16 * 176, I_2 = 44 * 32, I_L = I_IN + I_OUT + I_13 + I_2, I_MOD = 384;
    for (int it = gw; it < I_MOD + I_L; it += NGW) {
        if (it < I_MOD) {
            const int l = it / 192, r = it % 192, cb = r >> 3, ks = r & 7;
            const float* W = P.w_mod + (size_t)l * 1024 * NMODV + (size_t)(ks * 128) * NMODV + cb * 256 + 4 * lane;
            f32x4 a0 = {0.f, 0.f, 0.f, 0.f}, a1 = a0, a2 = a0;
#pragma unroll 8
            for (int k = 0; k < 128; ++k) { const f32x4 w = *(const f32x4*)(W + (size_t)k * NMODV); const int kk = ks * 128 + k;
                a0 += SC[kk] * w; a1 += SC[1024 + kk] * w; a2 += SC[2048 + kk] * w; }
            float* MP = (float*)(P.ws + WS_MODP) + (size_t)((l * 8 + ks) * 3) * NMODV + cb * 256 + 4 * lane;
            *(f32x4*)MP = a0; *(f32x4*)(MP + NMODV) = a1; *(f32x4*)(MP + 2 * NMODV) = a2;
            continue;
        }
        prep_weight_item(P, 0, it - I_MOD, scr, lane);
    }
    for (int i = bid * 512 + tid; i < 256 * 32; i += G * 512) { const int pos = i >> 5, fi = i & 31;
        const float inv = powf(10000.0f, -(float)(2 * fi) / 64.0f); const float ang = (float)pos * inv;
        ((float2*)(P.ws + WS_ROPE))[i] = make_float2(cosf(ang), sinf(ang)); }
}
__device__ __forceinline__ void phase_modreduce(const Params& P, int tid, int G, const int bid) {
    const float* MP = (const float*)(P.ws + WS_MODP); float* MOD = (float*)(P.ws + WS_MOD);
    for (int i = bid * 512 + tid; i < 2 * 3 * NMODV; i += G * 512) { const int l = i / (3 * NMODV), r = i % (3 * NMODV), wh = r / NMODV, col = r % NMODV;
        float v = P.b_mod[l * NMODV + col];
#pragma unroll
        for (int ks = 0; ks < 8; ++ks) v += MP[(size_t)((l * 8 + ks) * 3 + wh) * NMODV + col];
        MOD[i] = v; }
}

template <class T>
__device__ __forceinline__ void phase_norm(const T* xl, const T* xc, const float* nw, const float* mod  , int sh_off, int sc_off,
                                           bf16u* HN, int skip_ctx, int lane, int wave, int G, const int bid) {
    const int gw = bid * 8 + wave, NGW = G * 8; int cur = -1; f32x4 a[4], s[4];
    for (int m = gw; m < MROWS; m += NGW) {
        const int b = m / SEQU, j = m % SEQU; const bool isc = j < CTXL; if (isc && skip_ctx) continue;
        const int wh = isc ? 2 : b; const T* src = isc ? xc + (size_t)(b * CTXL + j) * DM : xl + (size_t)(b * LSEQ + j - CTXL) * DM;
        if (wh != cur) { cur = wh;
#pragma unroll
            for (int jj = 0; jj < 4; ++jj) { const int k = 8 * lane + 4 * (jj & 1) + 512 * (jj >> 1); const f32x4 w = *(const f32x4*)(nw + k), sc = *(const f32x4*)(mod + wh * NMODV + sc_off + k);
                a[jj] = w * (sc + 1.0f); s[jj] = *(const f32x4*)(mod + wh * NMODV + sh_off + k); } }
        f32x4 v[4]; float ss = 0.f;
#pragma unroll
        for (int h = 0; h < 2; ++h) pg8::ld8(src + 8 * lane + 512 * h, v[2 * h], v[2 * h + 1]);
#pragma unroll
        for (int jj = 0; jj < 4; ++jj) ss += (v[jj].x * v[jj].x + v[jj].y * v[jj].y) + (v[jj].z * v[jj].z + v[jj].w * v[jj].w);
        const float rstd = rsqrtf(wave_sum(ss, lane) * (1.0f / DM) + EPSN);
#pragma unroll
        for (int h = 0; h < 2; ++h) pg8::st8(HN + (size_t)m * DM + 8 * lane + 512 * h, (v[2 * h] * rstd) * a[2 * h] + s[2 * h], (v[2 * h + 1] * rstd) * a[2 * h + 1] + s[2 * h + 1]);
    }
}

__device__ __forceinline__ float ssd_dt_arrays(const Params& P, int l, int row0, float* ARR_dt, float* ARR_acs, int lane, int wave) {
    const float* DT = (const float*)(P.ws + WS_DT);
    const float bias = P.dt_bias[l * 8 + wave], A = -__expf(P.a_log[l * 8 + wave]) * 1.4426950408889634f;
    const float d0 = softplusf(DT[(size_t)(row0 + lane) * 8 + wave] + bias), d1 = softplusf(DT[(size_t)(row0 + 64 + lane) * 8 + wave] + bias);
    float p0 = d0 * A, p1 = d1 * A, tot;
    if (wave < 4) {
#pragma unroll
        for (int o = 1; o < 64; o <<= 1) { const float t0 = bperm(p0, lane - o), t1 = bperm(p1, lane - o); if (lane >= o) { p0 += t0; p1 += t1; } }
        const float tot0 = rdlane(p0, 63); p1 += tot0; tot = rdlane(p1, 63);
    } else {
#pragma unroll
        for (int o = 1; o < 64; o <<= 1) { const float t0 = bperm(p0, lane + o), t1 = bperm(p1, lane + o); if (lane + o < 64) { p0 += t0; p1 += t1; } }
        const float tot1 = rdlane(p1, 0); p0 += tot1; tot = rdlane(p0, 0);
    }
    ARR_dt[wave * 128 + lane] = d0; ARR_dt[wave * 128 + 64 + lane] = d1; ARR_acs[wave * 128 + lane] = p0; ARR_acs[wave * 128 + 64 + lane] = p1;
    return tot;
}
constexpr int XT_LD = 136;
__device__ __forceinline__ int xt_row(int ch) { return ch * XT_LD + (ch >> 3) * 8; }
constexpr int XT_BYTES = (256 * XT_LD + 32 * 8) * 2, BT_BYTES = (128 * XT_LD + 16 * 8) * 2;

#ifndef MIX_CHUNK_REP
#define MIX_CHUNK_REP 1
#endif
#ifndef MIX_POOL_REP
#define MIX_POOL_REP 1
#endif
__device__ __forceinline__ void phase_mixprep(const Params& P, int l, unsigned char* lds, int tid, int lane, int wave, int G, const int bid, const bool do_qk) {
    bf16u* U = (bf16u*)(P.ws + WS_U); bf16u* XBC = (bf16u*)(P.ws + WS_XBC); bf16u* MIX = (bf16u*)(P.ws + WS_MIX);
    const int fr = lane & 15, fq = lane >> 4;
    {
        bf16u* XT = (bf16u*)lds; bf16u* BT = (bf16u*)(lds + XT_BYTES); float* ARR_dt = (float*)(lds + XT_BYTES + BT_BYTES); float* ARR_acs = (float*)(lds + XT_BYTES + BT_BYTES + 4096);
        const int cbk = tid & 63, tq = tid >> 6;
        float cw[5][8], cbv[8];
#pragma unroll
        for (int j = 0; j < 5; ++j)
#pragma unroll
            for (int c = 0; c < 8; ++c) cw[j][c] = P.conv_w[(size_t)(l * 5 + j) * 512 + 8 * cbk + c];
#pragma unroll
        for (int c = 0; c < 8; ++c) cbv[c] = P.conv_b[l * 512 + 8 * cbk + c];
        for (int _cr = 0; _cr < MIX_CHUNK_REP; ++_cr)
        for (int ci = bid; ci < NCHUNK; ci += G) {
            const int b = ci / CPB, cb = ci % CPB, row0 = ci * 128;
            const int seq_lo = b * SEQU + (cb < 2 ? 0 : CTXL), seq_hi = b * SEQU + (cb < 2 ? CTXL : SEQU);
            const float tot = ssd_dt_arrays(P, l, row0, ARR_dt, ARR_acs, lane, wave);
            if (lane == 0) ((float*)(P.ws + WS_CD))[ci * 8 + wave] = __builtin_amdgcn_exp2f(tot);
            float win[5][8], olo[8]; unsigned tp[8][4];
#pragma unroll
            for (int j = 0; j < 4; ++j) { const int rr = row0 + 16 * tq + j - 2; u32x4 raw = {0u, 0u, 0u, 0u};
                if (rr >= seq_lo && rr < seq_hi) raw = *(const u32x4*)(U + (size_t)rr * NU + 512 + 8 * cbk);
                win[j][0] = bflo(raw.x); win[j][1] = bfhi(raw.x); win[j][2] = bflo(raw.y); win[j][3] = bfhi(raw.y); win[j][4] = bflo(raw.z); win[j][5] = bfhi(raw.z); win[j][6] = bflo(raw.w); win[j][7] = bfhi(raw.w); }
#pragma unroll
            for (int p = 0; p < 16; ++p) {
                const int tau = 16 * tq + p, rr = row0 + tau + 2; u32x4 raw = {0u, 0u, 0u, 0u};
                if (rr >= seq_lo && rr < seq_hi) raw = *(const u32x4*)(U + (size_t)rr * NU + 512 + 8 * cbk);
                { const int sl = (p + 4) % 5; win[sl][0] = bflo(raw.x); win[sl][1] = bfhi(raw.x); win[sl][2] = bflo(raw.y); win[sl][3] = bfhi(raw.y); win[sl][4] = bflo(raw.z); win[sl][5] = bfhi(raw.z); win[sl][6] = bflo(raw.w); win[sl][7] = bfhi(raw.w); }
                float o[8];
#pragma unroll
                for (int c = 0; c < 8; ++c) { float acc = cbv[c];
#pragma unroll
                    for (int j = 0; j < 5; ++j) acc += cw[j][c] * win[(p + j) % 5][c];
                    o[c] = siluf(acc); }
                u32x4 w; w.x = pk2(o[0], o[1]); w.y = pk2(o[2], o[3]); w.z = pk2(o[4], o[5]); w.w = pk2(o[6], o[7]);
                *(u32x4*)(XBC + (size_t)(row0 + tau) * 512 + 8 * cbk) = w;
                if ((p & 1) == 0) {
#pragma unroll
                    for (int c = 0; c < 8; ++c) olo[c] = o[c];
                } else {
#pragma unroll
                    for (int c = 0; c < 8; ++c) tp[c][(p & 7) >> 1] = pk2(olo[c], o[c]);
                }
                if ((p & 7) == 7 && cbk < 48) {
                    bf16u* T = (cbk < 32 ? XT + xt_row(8 * cbk) : BT + xt_row(8 * (cbk - 32))) + 16 * tq + (p - 7);
#pragma unroll
                    for (int c = 0; c < 8; ++c) { u32x4 tw = {tp[c][0], tp[c][1], tp[c][2], tp[c][3]}; *(u32x4*)(T + c * XT_LD) = tw; }
                }
            }
            __syncthreads();
            {
                const int h = wave & 3, g = h >> 1;
                f32x4 acc[4][4];
#pragma unroll
                for (int m = 0; m < 4; ++m)
#pragma unroll
                    for (int n = 0; n < 4; ++n) acc[m][n] = (f32x4){0.f, 0.f, 0.f, 0.f};
#pragma unroll
                for (int ks = 0; ks < 4; ++ks) {
                    const int tb = 32 * ks + 8 * fq; float wg[8];
#pragma unroll
                    for (int j = 0; j < 8; ++j) wg[j] = __builtin_amdgcn_exp2f(tot - ARR_acs[wave * 128 + tb + j]) * ARR_dt[wave * 128 + tb + j];
                    bf16x8 Af[4], Bf[4];
#pragma unroll
                    for (int m = 0; m < 4; ++m) { const u32x4 raw = *(const u32x4*)(XT + xt_row(h * 64 + 16 * m + fr) + tb);
                        u32x4 sc; sc.x = pk2(bflo(raw.x) * wg[0], bfhi(raw.x) * wg[1]); sc.y = pk2(bflo(raw.y) * wg[2], bfhi(raw.y) * wg[3]);
                        sc.z = pk2(bflo(raw.z) * wg[4], bfhi(raw.z) * wg[5]); sc.w = pk2(bflo(raw.w) * wg[6], bfhi(raw.w) * wg[7]);
                        Af[m] = __builtin_bit_cast(bf16x8, sc); }
#pragma unroll
                    for (int n = 0; n < 4; ++n) Bf[n] = *(const bf16x8*)(BT + xt_row(g * 64 + 16 * n + fr) + tb);
#pragma unroll
                    for (int m = 0; m < 4; ++m)
#pragma unroll
                        for (int n = 0; n < 4; ++n) acc[m][n] = __builtin_amdgcn_mfma_f32_16x16x32_bf16(Bf[n], Af[m], acc[m][n], 0, 0, 0);
                }
                float* ST = (float*)(P.ws + WS_ST) + (size_t)(ci * 8 + wave) * 4096;
#pragma unroll
                for (int m = 0; m < 4; ++m)
#pragma unroll
                    for (int n = 0; n < 4; ++n) *(f32x4*)(ST + (16 * m + fr) * 64 + 16 * n + 4 * fq) = acc[m][n];
            }
            __syncthreads();
        }
    }
    {
        bf16u* UT = (bf16u*)lds; bf16u* PL = (bf16u*)(lds + 40960); constexpr int PL_LD = 264;
        const int g = wave & 3, th = wave >> 2;
        bf16x8 Wf[4][2];
#pragma unroll
        for (int nt = 0; nt < 4; ++nt)
#pragma unroll
            for (int ks = 0; ks < 2; ++ks) { const float* wp = P.pool_w + (size_t)((l * 4 + g) * 64 + 32 * ks + 8 * fq) * 64 + 16 * nt + fr;
                u32x4 w; w.x = pk2(wp[0], wp[64]); w.y = pk2(wp[128], wp[192]); w.z = pk2(wp[256], wp[320]); w.w = pk2(wp[384], wp[448]); Wf[nt][ks] = __builtin_bit_cast(bf16x8, w); }
        f32x4 pscv[4];
#pragma unroll
        for (int nt = 0; nt < 4; ++nt) pscv[nt] = *(const f32x4*)(P.pool_scale + l * 256 + g * 64 + 16 * nt + 4 * fq);
        const int nx = (NCHUNK > G && NCHUNK - G < G / 2) ? NCHUNK - G : 0, vb = bid - nx, GV = G - nx;
        for (int _pr = 0; _pr < MIX_POOL_REP; ++_pr)
        if (bid >= nx)
        for (int pi = vb; pi < 2 * NCHUNK; pi += GV) {
            const int row0 = pi * 64, b = row0 / SEQU, j0 = row0 % SEQU; const bool isc = j0 < CTXL; if (isc && l == 1) continue;
            const int seq_lo = b * SEQU + (isc ? 0 : CTXL), seq_hi = b * SEQU + (isc ? CTXL : SEQU);
            for (int q = tid; q < 80 * 32; q += 512) { const int rl = q >> 5, cp = q & 31, rr = row0 - 8 + rl;
                u32x4 v = {0u, 0u, 0u, 0u}; if (rr >= seq_lo && rr < seq_hi) v = *(const u32x4*)(U + (size_t)rr * NU + 8 * cp);
                *(u32x4*)(UT + rl * 256 + 8 * cp) = v; }
            __syncthreads();
            { const int ch = tid & 255, hf = tid >> 8, gg = ch >> 6, w = 2 << gg, hw = w >> 1;
              const bf16u* col = UT + ch;
              const int t0 = hf * 32; float sum = 0.f;
              for (int k = -hw; k < hw; ++k) sum += bf2f(col[(t0 + k + 8) * 256]);
#pragma unroll 8
              for (int tt = 0; tt < 32; ++tt) { const int t = t0 + tt, r = row0 + t; int lo = r - hw, hi = lo + w; lo = lo < seq_lo ? seq_lo : lo; hi = hi > seq_hi ? seq_hi : hi;
                  PL[t * PL_LD + ch] = f2bf1(sum * __builtin_amdgcn_rcpf((float)(hi - lo)) - bf2f(col[(t + 8) * 256]));
                  sum += bf2f(col[(t + hw + 8) * 256]) - bf2f(col[(t - hw + 8) * 256]); } }
            __syncthreads();
#pragma unroll
            for (int mt = 0; mt < 2; ++mt) {
                const int t = th * 32 + mt * 16 + fr; bf16x8 Af[2];
#pragma unroll
                for (int ks = 0; ks < 2; ++ks) Af[ks] = *(const bf16x8*)(PL + t * PL_LD + g * 64 + 32 * ks + 8 * fq);
#pragma unroll
                for (int nt = 0; nt < 4; ++nt) { f32x4 acc = {0.f, 0.f, 0.f, 0.f};
#pragma unroll
                    for (int ks = 0; ks < 2; ++ks) acc = __builtin_amdgcn_mfma_f32_16x16x32_bf16(Wf[nt][ks], Af[ks], acc, 0, 0, 0);
                    acc = acc * pscv[nt]; u32x2 w; w.x = pk2(acc.x, acc.y); w.y = pk2(acc.z, acc.w);
                    *(u32x2*)(MIX + (size_t)(row0 + t) * DM + g * 64 + 16 * nt + 4 * fq) = w; } }
            __syncthreads();
        }
    }
    if (do_qk) {
        const int l32 = lane & 31, hw = lane >> 5; const float2* ROPE = (const float2*)(P.ws + WS_ROPE);
        const f32x4 kw = *(const f32x4*)(P.k_norm_w + l * 128 + 4 * l32);
        const int nxk = (NCHUNK > G && NCHUNK - G < G / 2) ? NCHUNK - G : 0; const int gw = bid >= nxk ? (bid - nxk) * 8 + wave : MROWS, NGW = (G - nxk) * 8;
        for (int m0 = gw; m0 < MROWS; m0 += 4 * NGW) {
            u32x2 raw[4];
#pragma unroll
            for (int q = 0; q < 4; ++q) { const int m = m0 + q * NGW; raw[q] = (u32x2){0u, 0u}; if (m < MROWS) raw[q] = *(const u32x2*)(U + (size_t)m * NU + 1536 + 128 * hw + 4 * l32); }
#pragma unroll
            for (int q = 0; q < 4; ++q) { const int m = m0 + q * NGW; if (m >= MROWS) continue;
                const int j = m % SEQU; const bool isc = j < CTXL; const int t = j - CTXL;
                const int pos = l32 < 16 ? (t >> 6) : (t & 63); const int ii = 4 * (l32 & 7);
                f32x4 cs = {1.f, 1.f, 1.f, 1.f}, sn = {0.f, 0.f, 0.f, 0.f};
                if (!isc) { const float2 r0 = ROPE[pos * 32 + ii], r1 = ROPE[pos * 32 + ii + 1], r2 = ROPE[pos * 32 + ii + 2], r3 = ROPE[pos * 32 + ii + 3];
                    cs = (f32x4){r0.x, r1.x, r2.x, r3.x}; sn = (f32x4){r0.y, r1.y, r2.y, r3.y}; }
                bf16u* p = U + (size_t)m * NU + 1536 + 128 * hw + 4 * l32;
                f32x4 v = {bflo(raw[q].x), bfhi(raw[q].x), bflo(raw[q].y), bfhi(raw[q].y)};
                float ss = (v.x * v.x + v.y * v.y) + (v.z * v.z + v.w * v.w);
#pragma unroll
                for (int o = 1; o < 32; o <<= 1) ss += bperm(ss, lane ^ o);
                const float rstd = rsqrtf(ss * (1.0f / 128.0f) + EPSN); v = (v * rstd) * kw;
                f32x4 pr; pr.x = bperm(v.x, lane ^ 8); pr.y = bperm(v.y, lane ^ 8); pr.z = bperm(v.z, lane ^ 8); pr.w = bperm(v.w, lane ^ 8);
                const f32x4 o = (l32 & 8) ? (pr * sn + v * cs) : (v * cs - pr * sn);
                u32x2 w; w.x = pk2(o.x, o.y); w.y = pk2(o.z, o.w); *(u32x2*)p = w; }
        }
    }
}

__device__ __forceinline__ void phase_scan(const Params& P, int tid, int G, const int bid) {
    const float* ST = (const float*)(P.ws + WS_ST); const float* CD = (const float*)(P.ws + WS_CD); bf16u* SP = (bf16u*)(P.ws + WS_SP);
    if (tid < 256)
    for (int e = bid * 256 + tid; e < 65536; e += G * 256) {
        const int combo = e >> 12, idx = e & 4095, b = combo >> 3, dh = combo & 7, d = dh >> 2; float S = 0.f;
        for (int s0 = 0; s0 < CPB; s0 += 10) { float stv[10], cdv[10]; size_t off[10];
#pragma unroll
            for (int q = 0; q < 10; ++q) { const int step = s0 + q; const int cb = d == 0 ? step : (step < 2 ? 1 - step : CPB + 1 - step); const int ci = b * CPB + cb;
                off[q] = (size_t)(ci * 8 + dh) * 4096 + idx; stv[q] = ST[off[q]]; cdv[q] = CD[ci * 8 + dh]; }
#pragma unroll
            for (int q = 0; q < 10; ++q) { SP[off[q]] = f2bf1(S); S = cdv[q] * S + stv[q]; } }
    }
}
#ifndef ATTN_DUP
#define ATTN_DUP 1
#endif
#ifndef ATTN_FIX_LIMIT
#define ATTN_FIX_LIMIT 60.0f
#endif
__device__ __forceinline__ void phase_attn(const Params& P, int l, unsigned char* lds, int G, const int tid, const int bid) {
    const att::bf16* U = (const att::bf16*)(P.ws + WS_U); att::bf16* MIX = (att::bf16*)(P.ws + WS_MIX);
    float mfix;
    { const int lane = tid & 63; const float* qw = P.q_norm_w + l * 128; const float* kw = P.k_norm_w + l * 128;
      float mq = fmaxf(fabsf(qw[lane]), fabsf(qw[lane + 64])), mk = fmaxf(fabsf(kw[lane]), fabsf(kw[lane + 64]));
#pragma unroll
      for (int o = 1; o < 64; o <<= 1) { mq = fmaxf(mq, bperm(mq, lane ^ o)); mk = fmaxf(mk, bperm(mk, lane ^ o)); }
      mfix = 128.0f * 1.001f * mq * mk * (att::SCALE * 1.4426950408889634f); }
    const bool has_cu = (l == 0 && (bid & 31) == 0 && (bid >> 5) < 8);
    if (mfix <= ATTN_FIX_LIMIT) {
#pragma unroll 1
    for (int u0 = has_cu ? -1 : (int)bid; u0 < 512 * ATTN_DUP; u0 = (u0 < 0 ? (int)bid : u0 + G)) {
        const int u = u0 < 0 ? u0 : (u0 & 511);
        size_t r0, rq; int h, kvh, seq;
        if (u < 0) { const int cu = bid >> 5; const int b = cu >> 2; h = cu & 3; kvh = h >> 1; r0 = (size_t)b * SEQU; rq = r0; seq = CTXL; }
        else { const int xcd = u & 7, slot = (u >> 3) & 31, i = u >> 8, combo = xcd >> 1, b = combo >> 1; kvh = combo & 1; h = 2 * kvh + (xcd & 1); const int qb = i * 32 + slot;
            r0 = (size_t)b * SEQU; rq = r0 + CTXL + (size_t)qb * 256; seq = SEQU; }
        att::attn_dense_body_dma<att::bf16>(U + rq * NU + 1024 + h * 128, U + r0 * NU + 1536 + kvh * 128, U + r0 * NU + 1792 + kvh * 128, MIX + rq * DM + 512 + h * 128, seq, (char*)lds, tid, P.q_norm_w + l * 128, (const float2*)(P.ws + WS_ROPE), u < 0 ? -1 : (int)(rq - r0 - CTXL));
        __syncthreads();
    }
    } else {
#pragma unroll 1
    for (int u0 = has_cu ? -1 : (int)bid; u0 < 512 * ATTN_DUP; u0 = (u0 < 0 ? (int)bid : u0 + G)) {
        const int u = u0 < 0 ? u0 : (u0 & 511);
        size_t r0, rq; int h, kvh, seq;
        if (u < 0) { const int cu = bid >> 5; const int b = cu >> 2; h = cu & 3; kvh = h >> 1; r0 = (size_t)b * SEQU; rq = r0; seq = CTXL; }
        else { const int xcd = u & 7, slot = (u >> 3) & 31, i = u >> 8, combo = xcd >> 1, b = combo >> 1; kvh = combo & 1; h = 2 * kvh + (xcd & 1); const int qb = i * 32 + slot;
            r0 = (size_t)b * SEQU; rq = r0 + CTXL + (size_t)qb * 256; seq = SEQU; }
        att::attn_dense_body<att::bf16, false>(U + rq * NU + 1024 + h * 128, U + r0 * NU + 1536 + kvh * 128, U + r0 * NU + 1792 + kvh * 128, MIX + rq * DM + 512 + h * 128, seq, (char*)lds, tid, P.q_norm_w + l * 128, (const float2*)(P.ws + WS_ROPE), u < 0 ? -1 : (int)(rq - r0 - CTXL));
        __syncthreads();
    }
    }
}

#ifndef SSD_STAGE_REP
#define SSD_STAGE_REP 1
#endif
#ifndef SSD_HEAD_REP
#define SSD_HEAD_REP 1
#endif
__device__ __forceinline__ void phase_ssdout(const Params& P, int l, unsigned char* lds, int tid, int lane, int wave, int G, const int bid) {
    const bf16u* U = (const bf16u*)(P.ws + WS_U); const bf16u* XBC = (const bf16u*)(P.ws + WS_XBC); bf16u* MIX = (bf16u*)(P.ws + WS_MIX); const bf16u* SP = (const bf16u*)(P.ws + WS_SP);
    bf16u* XT = (bf16u*)lds; float* ARR_dt = (float*)(lds + XT_BYTES); float* ARR_acs = (float*)(lds + XT_BYTES + 4096); bf16u* BC = (bf16u*)(lds + XT_BYTES + 8192);
    constexpr int BC_LD = 264;
    const int fr = lane & 15, fq = lane >> 4;
    for (int ci = bid; ci < NCHUNK; ci += G) {
        const int cb = ci % CPB, row0 = ci * 128; if (l == 1 && cb < 2) continue;
        (void)ssd_dt_arrays(P, l, row0, ARR_dt, ARR_acs, lane, wave);
        for (int _sr = 0; _sr < SSD_STAGE_REP; ++_sr) {
            const int cp = tid & 63, rg = tid >> 6;
#pragma unroll
            for (int k = 0; k < 2; ++k) { const int tb0 = 16 * rg + 8 * k; u32x4 w[8];
#pragma unroll
                for (int j = 0; j < 8; ++j) w[j] = *(const u32x4*)(XBC + (size_t)(row0 + tb0 + j) * 512 + 8 * cp);
                if (cp < 32) { bf16u* T = XT + xt_row(8 * cp) + tb0;
#pragma unroll
                    for (int c2 = 0; c2 < 4; ++c2) {
                        u32x4 lo, hi;
                        lo.x = (w[0][c2] & 0xffffu) | (w[1][c2] << 16); lo.y = (w[2][c2] & 0xffffu) | (w[3][c2] << 16); lo.z = (w[4][c2] & 0xffffu) | (w[5][c2] << 16); lo.w = (w[6][c2] & 0xffffu) | (w[7][c2] << 16);
                        hi.x = (w[0][c2] >> 16) | (w[1][c2] & 0xffff0000u); hi.y = (w[2][c2] >> 16) | (w[3][c2] & 0xffff0000u); hi.z = (w[4][c2] >> 16) | (w[5][c2] & 0xffff0000u); hi.w = (w[6][c2] >> 16) | (w[7][c2] & 0xffff0000u);
                        *(u32x4*)(T + (2 * c2) * XT_LD) = lo; *(u32x4*)(T + (2 * c2 + 1) * XT_LD) = hi; } }
                else {
#pragma unroll
                    for (int j = 0; j < 8; ++j) *(u32x4*)(BC + (size_t)(tb0 + j) * BC_LD + 8 * (cp - 32)) = w[j]; } }
        }
        __syncthreads();
        const int tau = 16 * wave + fr, r = row0 + tau;
        f32x4 Gm[8];
#pragma unroll
        for (int nt = 0; nt < 8; ++nt) Gm[nt] = (f32x4){0.f, 0.f, 0.f, 0.f};
        f32x4 Yp[4]; float ssq_p = 0.f;
#pragma unroll
        for (int pt = 0; pt < 4; ++pt) Yp[pt] = (f32x4){0.f, 0.f, 0.f, 0.f};
#pragma unroll 1
        for (int h0 = 0; h0 < 4 * SSD_HEAD_REP; ++h0) {
            const int h = h0 & 3, g = h >> 1;
            f32x4 Y[4];
#pragma unroll
            for (int pt = 0; pt < 4; ++pt) Y[pt] = (f32x4){0.f, 0.f, 0.f, 0.f};
            bf16x8 Cf[2];
            bf16x8 Sf[2][4][2];
#pragma unroll
            for (int d = 0; d < 2; ++d) { const bf16u* sp = SP + (size_t)(ci * 8 + d * 4 + h) * 4096 + fr * 64 + 8 * fq;
#pragma unroll
                for (int pt = 0; pt < 4; ++pt)
#pragma unroll
                    for (int ks = 0; ks < 2; ++ks) Sf[d][pt][ks] = *(const bf16x8*)(sp + (16 * pt) * 64 + 32 * ks); }
            const float dsk = P.d_skip[l * 8 + h] + P.d_skip[l * 8 + 4 + h];
            u32x2 xrv[4], zrv[4];
            { const bf16u* xrp = XBC + (size_t)r * 512 + h * 64 + 4 * fq; const bf16u* zrp = U + (size_t)r * NU + 256 + h * 64 + 4 * fq;
#pragma unroll
              for (int pt = 0; pt < 4; ++pt) { xrv[pt] = *(const u32x2*)(xrp + 16 * pt); zrv[pt] = *(const u32x2*)(zrp + 16 * pt); } }
            const bf16u* cp = BC + (size_t)tau * BC_LD + 128 + 64 * g + 8 * fq;
#pragma unroll
            for (int ks = 0; ks < 2; ++ks) Cf[ks] = *(const bf16x8*)(cp + 32 * ks);
            if ((h & 1) == 0) {
                const bf16u* bp = BC + (size_t)fr * BC_LD + 64 * g + 8 * fq;
#pragma unroll
                for (int nt = 0; nt < 8; ++nt) { Gm[nt] = (f32x4){0.f, 0.f, 0.f, 0.f};
#pragma unroll
                    for (int ks = 0; ks < 2; ++ks) { const bf16x8 Bf = *(const bf16x8*)(bp + nt * 16 * BC_LD + 32 * ks);
                        Gm[nt] = __builtin_amdgcn_mfma_f32_16x16x32_bf16(Bf, Cf[ks], Gm[nt], 0, 0, 0); } } }
            const float* acf = ARR_acs + h * 128; const float* acb = ARR_acs + (4 + h) * 128; const float* dtfp = ARR_dt + h * 128; const float* dtbp = ARR_dt + (4 + h) * 128;
            const float af_t = acf[tau], ab_t = acb[tau];
            int frl = fr; asm volatile("" : "+v"(frl));
            const bf16u* xtp = XT + xt_row(h * 64 + fr) + 4 * fq;
#pragma unroll
            for (int ks = 0; ks < 4; ++ks) {
                float mv[8];
#pragma unroll
                for (int hf = 0; hf < 2; ++hf) { const int nt = 2 * ks + hf, rho0 = 16 * nt + 4 * fq;
                    if (nt != wave) {
                        const bool lower = nt < wave; const float a_t = lower ? af_t : ab_t;
                        const f32x4 a_r = *(const f32x4*)((lower ? acf : acb) + rho0), dt_r = *(const f32x4*)((lower ? dtfp : dtbp) + rho0);
#pragma unroll
                        for (int i = 0; i < 4; ++i) mv[hf * 4 + i] = Gm[nt][i] * (__builtin_amdgcn_exp2f(a_t - a_r[i]) * dt_r[i]);
                    } else {
                        const f32x4 af_r = *(const f32x4*)(acf + rho0), ab_r = *(const f32x4*)(acb + rho0);
                        const f32x4 dtf = *(const f32x4*)(dtfp + rho0), dtb = *(const f32x4*)(dtbp + rho0);
#pragma unroll
                        for (int i = 0; i < 4; ++i) { const bool lw = (4 * fq + i) < frl;
                            const float arg = lw ? af_t - af_r[i] : ab_t - ab_r[i]; float f = __builtin_amdgcn_exp2f(arg) * (lw ? dtf[i] : dtb[i]);
                            if ((4 * fq + i) == frl) f = dtf[i] + dtb[i];
                            mv[hf * 4 + i] = Gm[nt][i] * f; }
                    } }
                u32x4 mw; mw.x = pk2(mv[0], mv[1]); mw.y = pk2(mv[2], mv[3]); mw.z = pk2(mv[4], mv[5]); mw.w = pk2(mv[6], mv[7]);
                const bf16x8 Mf = __builtin_bit_cast(bf16x8, mw);
#pragma unroll
                for (int pt = 0; pt < 4; ++pt) { const bf16u* xp = xtp + (16 * pt) * XT_LD + 2 * pt * 8 + 32 * ks;
                    const u32x2 x0 = *(const u32x2*)xp, x1 = *(const u32x2*)(xp + 16); const u32x4 xw = {x0.x, x0.y, x1.x, x1.y};
                    Y[pt] = __builtin_amdgcn_mfma_f32_16x16x32_bf16(__builtin_bit_cast(bf16x8, xw), Mf, Y[pt], 0, 0, 0); }
            }
#pragma unroll
            for (int d = 0; d < 2; ++d) {
                const float e = __builtin_amdgcn_exp2f(d == 0 ? af_t : ab_t);
#pragma unroll
                for (int pt = 0; pt < 4; ++pt) { f32x4 Z = {0.f, 0.f, 0.f, 0.f};
#pragma unroll
                    for (int ks = 0; ks < 2; ++ks) Z = __builtin_amdgcn_mfma_f32_16x16x32_bf16(Sf[d][pt][ks], Cf[ks], Z, 0, 0, 0);
                    Y[pt] += Z * e; }
            }
            float ssq = 0.f;
#pragma unroll
            for (int pt = 0; pt < 4; ++pt) {
                const u32x2 xr = xrv[pt], zr = zrv[pt];
                f32x4 y = Y[pt]; y.x += dsk * bflo(xr.x); y.y += dsk * bfhi(xr.x); y.z += dsk * bflo(xr.y); y.w += dsk * bfhi(xr.y);
                y.x *= siluf(bflo(zr.x)); y.y *= siluf(bfhi(zr.x)); y.z *= siluf(bflo(zr.y)); y.w *= siluf(bfhi(zr.y));
                Y[pt] = y; ssq += (y.x * y.x + y.y * y.y) + (y.z * y.z + y.w * y.w); }
            if ((h & 1) == 0) {
#pragma unroll
                for (int pt = 0; pt < 4; ++pt) Yp[pt] = Y[pt];
                ssq_p = ssq;
            } else {
                ssq += ssq_p; ssq += bperm(ssq, lane ^ 16); ssq += bperm(ssq, lane ^ 32); ssq = rsqrtf(ssq * (1.0f / 128.0f) + EPSN);
                const float* nwp = P.ssd_norm_w + l * 256 + (h - 1) * 64 + 4 * fq; bf16u* op = MIX + (size_t)r * DM + 256 + (h - 1) * 64 + 4 * fq;
#pragma unroll
                for (int pt = 0; pt < 4; ++pt) { const f32x4 o0 = Yp[pt] * ssq * *(const f32x4*)(nwp + 16 * pt), o1 = Y[pt] * ssq * *(const f32x4*)(nwp + 64 + 16 * pt);
                    u32x2 w0, w1; w0.x = pk2(o0.x, o0.y); w0.y = pk2(o0.z, o0.w); w1.x = pk2(o1.x, o1.y); w1.y = pk2(o1.z, o1.w);
                    *(u32x2*)(op + 16 * pt) = w0; *(u32x2*)(op + 64 + 16 * pt) = w1; }
            }
        }
        __syncthreads();
    }
}


template <int K, class RT, class OT>
__device__ __forceinline__ void ctx_gemm_resid(const bf16u* A  , const bf16u* Wt  , const RT* res_ctx, OT* out_ctx, const float* gate_ctx,
                                               unsigned char* lds, int tid, int lane, int wave, int G, int bid) {
    constexpr int KW = K / 8, PLD = 68; static_assert(KW % 32 == 0, "K/8 must be a multiple of the MFMA k-step");
    const int fr = lane & 15, fq = lane >> 4; float* PS = (float*)lds;
    for (int it = bid; it < 128; it += G) {
        const int mt = it >> 4, nt64 = it & 15;
        const bf16u* ap[4]; const bf16u* bp[4];
#pragma unroll
        for (int q = 0; q < 4; ++q) { const int c = mt * 64 + q * 16 + fr;
            ap[q] = A + ((size_t)(c >> 8) * SEQU + (c & 255)) * K + wave * KW + 8 * fq;
            bp[q] = Wt + (size_t)(nt64 * 64 + q * 16 + fr) * K + wave * KW + 8 * fq; }
        f32x4 acc[4][4];
#pragma unroll
        for (int mi = 0; mi < 4; ++mi)
#pragma unroll
            for (int ni = 0; ni < 4; ++ni) acc[mi][ni] = (f32x4){0.f, 0.f, 0.f, 0.f};
#pragma unroll 4
        for (int k = 0; k < KW; k += 32) { bf16x8 af[4], bfr[4];
#pragma unroll
            for (int q = 0; q < 4; ++q) { af[q] = *(const bf16x8*)(ap[q] + k); bfr[q] = *(const bf16x8*)(bp[q] + k); }
#pragma unroll
            for (int mi = 0; mi < 4; ++mi)
#pragma unroll
                for (int ni = 0; ni < 4; ++ni) acc[mi][ni] = __builtin_amdgcn_mfma_f32_16x16x32_bf16(bfr[ni], af[mi], acc[mi][ni], 0, 0, 0); }
#pragma unroll
        for (int mi = 0; mi < 4; ++mi)
#pragma unroll
            for (int ni = 0; ni < 4; ++ni) *(f32x4*)(PS + (size_t)(wave * 64 + 16 * mi + fr) * PLD + 16 * ni + 4 * fq) = acc[mi][ni];
        __syncthreads();
        { const int row = tid >> 3, c8 = (tid & 7) * 8; f32x4 s0 = {0.f, 0.f, 0.f, 0.f}, s1 = s0;
#pragma unroll
          for (int w = 0; w < 8; ++w) { s0 += *(const f32x4*)(PS + (size_t)(w * 64 + row) * PLD + c8); s1 += *(const f32x4*)(PS + (size_t)(w * 64 + row) * PLD + c8 + 4); }
          const int col = nt64 * 64 + c8; const size_t o = (size_t)(mt * 64 + row) * DM + col; f32x4 r0, r1; pg8::ld8(res_ctx + o, r0, r1);
          pg8::st8(out_ctx + o, r0 + *(const f32x4*)(gate_ctx + col) * s0, r1 + *(const f32x4*)(gate_ctx + col + 4) * s1); }
        __syncthreads();
    }
}

#define LAS __attribute__((address_space(3)))
#define XB_TMO      128
#define XB_XCNT(j)  (256  + 64 * (j))
#define XB_XSUB(j)  (1280 + 64 * (j))
#define XB_XGEN(j)  (2304 + 64 * (j))
#define XB_TOP      3328
#define XB_TOPGEN   3392
#define XCD_BAR_WORDS 3456
#define XB_SPIN_CAP (1u << 18)

__device__ __forceinline__ unsigned xb_ld(unsigned* p)              { return __hip_atomic_load(p, __ATOMIC_RELAXED, __HIP_MEMORY_SCOPE_AGENT); }
__device__ __forceinline__ unsigned xb_add(unsigned* p, unsigned v) { return __hip_atomic_fetch_add(p, v, __ATOMIC_RELAXED, __HIP_MEMORY_SCOPE_AGENT); }
__device__ __forceinline__ unsigned xb_xcc_id() { return (unsigned)__builtin_amdgcn_s_getreg((3 << 11) | 20) & 0xFu; }
#define XB_SPIN(cond, bar) do { unsigned _sp = 0; while (cond) { __builtin_amdgcn_s_sleep(1); \
    if ((++_sp & 255u) == 0u) { if (xb_ld(&(bar)[XB_TMO])) break; if (_sp > XB_SPIN_CAP) { atomicAdd(&(bar)[XB_TMO], 1u); break; } } } } while (0)

struct XcdBarrier {
    unsigned* bar; unsigned x;
    volatile LAS unsigned* st;
};

__device__ __forceinline__ XcdBarrier xcd_barrier_post(unsigned* bar, volatile LAS unsigned* st, const int tid_) {
    XcdBarrier b; b.bar = bar; b.x = xb_xcc_id(); b.st = st;
    if (tid_ == 0) (void)xb_add(&bar[XB_XCNT(b.x)], 1u);
    return b;
}
__device__ __forceinline__ void xcd_barrier_complete(unsigned* bar, unsigned x, unsigned& nloc, unsigned& nx) {
    const unsigned G = gridDim.x * gridDim.y * gridDim.z;
    unsigned sum, cnt, mine, sp = 0u;
    for (;;) {
        sum = 0u; cnt = 0u; mine = 0u;
#pragma unroll
        for (unsigned j = 0; j < 16; ++j) { const unsigned c = xb_ld(&bar[XB_XCNT(j)]); sum += c; cnt += (c > 0u) ? 1u : 0u; mine = (j == x) ? c : mine; }
        if (sum == G) break;
        __builtin_amdgcn_s_sleep(1);
        if ((++sp & 255u) == 0u) { if (xb_ld(&bar[XB_TMO])) break; if (sp > XB_SPIN_CAP) { atomicAdd(&bar[XB_TMO], 1u); break; } }
    }
    nloc = mine > 0u ? mine : 1u; nx = cnt > 0u ? cnt : 1u;
}

__device__ __forceinline__ void xcd_barrier(const XcdBarrier& b, const int tid_) {
    asm volatile("s_waitcnt vmcnt(0)" ::: "memory");
    __syncthreads();
    if (tid_ == 0) {
        unsigned* bar = b.bar;
        __builtin_amdgcn_s_waitcnt(0);
        unsigned nloc = b.st[0], nx = b.st[1];
        if (nloc == 0u) { xcd_barrier_complete(bar, b.x, nloc, nx); b.st[0] = nloc; b.st[1] = nx; }
        const unsigned old = xb_add(&bar[XB_XSUB(b.x)], 1u);
        const unsigned gen = old / nloc;
        if (old + 1u == (gen + 1u) * nloc) {
            __builtin_amdgcn_fence(__ATOMIC_RELEASE, "agent");
            asm volatile("s_waitcnt vmcnt(0)" ::: "memory");
            const unsigned og = xb_add(&bar[XB_TOP], 1u);
            const unsigned tg = og / nx;
            if (og + 1u == (tg + 1u) * nx) xb_add(&bar[XB_TOPGEN], 1u);
            else XB_SPIN(xb_ld(&bar[XB_TOPGEN]) == tg, bar);
            __builtin_amdgcn_fence(__ATOMIC_ACQUIRE, "agent");
            xb_add(&bar[XB_XGEN(b.x)], 1u);
            asm volatile("s_waitcnt vmcnt(0)" ::: "memory");
        } else {
            XB_SPIN(xb_ld(&bar[XB_XGEN(b.x)]) == gen, bar);
            __builtin_amdgcn_fence(__ATOMIC_ACQUIRE, "agent");
            asm volatile("s_waitcnt vmcnt(0)" ::: "memory");
        }
    }
    __syncthreads();
}

typedef unsigned long long u64t;
__device__ __forceinline__ u64t ld_tab(const __attribute__((address_space(3))) u64t* T, int i) { const u64t v = T[i];
    return (u64t)(unsigned)__builtin_amdgcn_readfirstlane((int)(unsigned)v) | ((u64t)(unsigned)__builtin_amdgcn_readfirstlane((int)(unsigned)(v >> 32)) << 32); }
#define GLB(T, v) ((T*)(__attribute__((address_space(1))) T*)(v))
__device__ __forceinline__ Params load_params(const __attribute__((address_space(3))) u64t* T, int lo, int hi) {
    Params Q;
    Q.x = GLB(const float, ld_tab(T, 0)); Q.c = GLB(const float, ld_tab(T, 1)); Q.ctx = GLB(const float, ld_tab(T, 2)); Q.c_ctx = GLB(const float, ld_tab(T, 3)); Q.norm1_w = GLB(const float, ld_tab(T, 4));
    Q.norm2_w = GLB(const float, ld_tab(T, 5)); Q.w_mod = GLB(const float, ld_tab(T, 6)); Q.b_mod = GLB(const float, ld_tab(T, 7)); Q.w_in = GLB(const float, ld_tab(T, 8)); Q.pool_w = GLB(const float, ld_tab(T, 9));
    Q.pool_scale = GLB(const float, ld_tab(T, 10)); Q.conv_w = GLB(const float, ld_tab(T, 11)); Q.conv_b = GLB(const float, ld_tab(T, 12)); Q.dt_bias = GLB(const float, ld_tab(T, 13)); Q.a_log = GLB(const float, ld_tab(T, 14));
    Q.d_skip = GLB(const float, ld_tab(T, 15)); Q.ssd_norm_w = GLB(const float, ld_tab(T, 16)); Q.q_norm_w = GLB(const float, ld_tab(T, 17)); Q.k_norm_w = GLB(const float, ld_tab(T, 18)); Q.w_out = GLB(const float, ld_tab(T, 19));
    Q.w1 = GLB(const float, ld_tab(T, 20)); Q.w3 = GLB(const float, ld_tab(T, 21)); Q.w2 = GLB(const float, ld_tab(T, 22)); Q.out = GLB(float, ld_tab(T, 23)); Q.ws = GLB(unsigned char, ld_tab(T, 24)); Q.ph_lo = lo; Q.ph_hi = hi;
    return Q;
}
__global__ void __launch_bounds__(512, 2) hybrid_fwd(Params P0) {
    extern __shared__ __attribute__((aligned(16))) unsigned char lds[];
    cg::grid_group grid = cg::this_grid();
    PG8_LAS unsigned char* ldsl = (PG8_LAS unsigned char*)lds;
    PG8_LAS u64t* TAB = (PG8_LAS u64t*)(ldsl + LDS_TAB);
    const int lo = P0.ph_lo, hi = P0.ph_hi;
    const int wave0 = __builtin_amdgcn_readfirstlane((int)threadIdx.x >> 6);
#define FRESH_TID(name) unsigned name##z_ = 0u; asm volatile("" : "+s"(name##z_)); int name = wave0 * 64 + (int)__builtin_amdgcn_mbcnt_hi(~0u, __builtin_amdgcn_mbcnt_lo(~0u, name##z_)); asm volatile("" : "+v"(name));
    if (threadIdx.x == 0) {
        TAB[0] = (u64t)P0.x; TAB[1] = (u64t)P0.c; TAB[2] = (u64t)P0.ctx; TAB[3] = (u64t)P0.c_ctx; TAB[4] = (u64t)P0.norm1_w; TAB[5] = (u64t)P0.norm2_w; TAB[6] = (u64t)P0.w_mod; TAB[7] = (u64t)P0.b_mod;
        TAB[8] = (u64t)P0.w_in; TAB[9] = (u64t)P0.pool_w; TAB[10] = (u64t)P0.pool_scale; TAB[11] = (u64t)P0.conv_w; TAB[12] = (u64t)P0.conv_b; TAB[13] = (u64t)P0.dt_bias; TAB[14] = (u64t)P0.a_log;
        TAB[15] = (u64t)P0.d_skip; TAB[16] = (u64t)P0.ssd_norm_w; TAB[17] = (u64t)P0.q_norm_w; TAB[18] = (u64t)P0.k_norm_w; TAB[19] = (u64t)P0.w_out; TAB[20] = (u64t)P0.w1; TAB[21] = (u64t)P0.w3;
        TAB[22] = (u64t)P0.w2; TAB[23] = (u64t)P0.out; TAB[24] = (u64t)P0.ws;
        ((PG8_LAS unsigned*)(ldsl + LDS_TAB + 256))[0] = 0u; ((PG8_LAS unsigned*)(ldsl + LDS_TAB + 256))[1] = 0u;
    }
    __syncthreads();
    if (blockIdx.x == 0) { for (int i = threadIdx.x; i < 4096; i += 512) ((unsigned*)(P0.ws + WS_BAR))[i] = 0u; }
    XcdBarrier bar; bar.bar = (unsigned*)(P0.ws + WS_BAR); bar.x = 0; bar.st = (volatile LAS unsigned*)(ldsl + LDS_TAB + 256);
#ifndef TMASK
#define TMASK 0xFFFF
#endif
#define EN(t) (((TMASK) >> (t)) & 1)
#ifndef DUPMASK
#define DUPMASK 0
#endif
#ifndef DUPMASK0
#define DUPMASK0 DUPMASK
#endif
#ifndef DUPMASK1
#define DUPMASK1 DUPMASK
#endif
#define NREP(t) (((((l_ == 0 ? (DUPMASK0) : (DUPMASK1))) >> (t)) & 1) ? 2 : 1)
#define IN(k) (lo <= (k) && (k) < hi)
#ifndef SCAN_DUP
#define SCAN_DUP 1
#endif
#ifndef BAR_DUP
#define BAR_DUP 1
#endif
#define SEAM(k) do { if (IN(k) && IN((k) + 1)) { if ((k) == 0) { grid.sync(); FRESH_TID(tb_); bar = xcd_barrier_post(bar.bar, bar.st, tb_); } else { FRESH_TID(tb_); for (int _b = 0; _b < BAR_DUP; ++_b) xcd_barrier(bar, tb_); } } } while (0)
#define FRESH() FRESH_TID(tid) int bid = blockIdx.x; asm volatile("" : "+s"(bid)); int G = gridDim.x; asm volatile("" : "+s"(G)); const int lane = tid & 63, wave = __builtin_amdgcn_readfirstlane(tid >> 6); (void)lane; (void)wave; \
    const Params P = load_params(TAB, lo, hi); unsigned char* const ws = P.ws; (void)ws;
    constexpr int l_ = 0;
    if (EN(0) && IN(0)) { for (int rep = 0; rep < NREP(0); ++rep) { FRESH(); phase_prep(P, lds, tid, lane, wave, G, bid); } } SEAM(0);
    if (EN(1) && IN(1)) { for (int rep = 0; rep < NREP(1); ++rep) { FRESH(); phase_modreduce(P, tid, G, bid); } } SEAM(1);
    { constexpr int l = 0; constexpr int l_ = 0;
        const int pb = 2 + 9 * l; const int skip = l;
#define LAYER_PTRS() const float* mod = (const float*)(ws + WS_MOD) + (size_t)l * 3 * NMODV; (void)mod; \
        bf16u* XSL = (bf16u*)(ws + WS_XSL); bf16u* XSC = (bf16u*)(ws + WS_XSC); (void)XSL; (void)XSC; bf16u* HN = (bf16u*)(ws + WS_HN); (void)HN;
        if (EN(2) && IN(pb + 0)) { for (int rep = 0; rep < NREP(2); ++rep) { FRESH(); LAYER_PTRS(); phase_norm<float>(P.x, P.ctx, P.norm1_w + l * DM, mod, 0, 1024, HN, 0, lane, wave, G, bid); } } SEAM(pb + 0);
        if (EN(3) && IN(pb + 1)) { for (int rep = 0; rep < NREP(3); ++rep) { FRESH(); LAYER_PTRS(); pg8::Gemm g{HN, (const bf16u*)(ws + WS_WIN) + (size_t)l * NIN * 1024, MROWS, NIN, DM}; pg8::OrderX S; S.init(MROWS / 256, NIN, G, bid, 0);
            pg8::EpiInProj E{(bf16u*)(ws + WS_U), (float*)(ws + WS_DT)};
            pg8::gemm_phase<pg8::EpiInProj, pg8::OrderX, true, true>(ldsl, g, S, E, tid); } } SEAM(pb + 1);
        if (EN(4) && IN(pb + 2)) { for (int rep = 0; rep < NREP(4); ++rep) { FRESH(); phase_mixprep(P, l, lds, tid, lane, wave, G, bid, rep == NREP(4) - 1); } } SEAM(pb + 2);
        if (EN(5) && IN(pb + 3)) { for (int rep = 0; rep < NREP(5); ++rep) { { FRESH(); for (int _s = 0; _s < SCAN_DUP; ++_s) phase_scan(P, tid, G, bid); } __syncthreads(); { FRESH(); phase_attn(P, l, lds, G, tid, bid); } } } SEAM(pb + 3);
        if (EN(6) && IN(pb + 4)) { for (int rep = 0; rep < NREP(6); ++rep) { FRESH(); phase_ssdout(P, l, lds, tid, lane, wave, G, bid); } } SEAM(pb + 4);
        if (EN(7) && IN(pb + 5)) { for (int rep = 0; rep < NREP(7); ++rep) { FRESH(); LAYER_PTRS(); if (l == 0) { ctx_gemm_resid<DM, float, bf16u>((const bf16u*)(ws + WS_MIX), (const bf16u*)(ws + WS_WOUT), P.ctx, XSC, mod + 2048 + 2 * NMODV, lds, tid, lane, wave, G, bid); __syncthreads(); }
            pg8::Gemm g{(const bf16u*)(ws + WS_MIX), (const bf16u*)(ws + WS_WOUT) + (size_t)l * 1024 * 1024, MROWS, DM, DM}; pg8::OrderX S; S.init(128, DM, G, bid, 1);
            pg8::EpiResid<float, bf16u> E{P.x, P.ctx, XSL, XSC, mod + 2048};
            pg8::gemm_phase<pg8::EpiResid<float, bf16u>, pg8::OrderX, true, true>(ldsl, g, S, E, tid); } } SEAM(pb + 5);
        if (EN(8) && IN(pb + 6)) { for (int rep = 0; rep < NREP(8); ++rep) { FRESH(); LAYER_PTRS(); phase_norm<bf16u>(XSL, XSC, P.norm2_w + l * DM, mod, 3072, 4096, HN, skip, lane, wave, G, bid); } } SEAM(pb + 6);
        if (EN(9) && IN(pb + 7)) { for (int rep = 0; rep < NREP(9); ++rep) { FRESH(); LAYER_PTRS(); pg8::Gemm g{HN, (const bf16u*)(ws + WS_W13) + (size_t)l * 2 * DFF * 1024, MROWS, 2 * DFF, DM}; pg8::OrderX S; S.init(skip ? 128 : 130, 2 * DFF, G, bid, skip);
            pg8::EpiSwiGLU E{(bf16u*)(ws + WS_ACT)};
            pg8::gemm_phase<pg8::EpiSwiGLU, pg8::OrderX, true, true>(ldsl, g, S, E, tid);
            if (l == 0) { const int nwg = 130 * 22, R = (nwg + G - 1) / G, fi = nwg - (R - 1) * G;
                if (nwg % G == 0) prep_layer1_weights(P, lds, lane, wave, bid, G); else if (bid >= fi) prep_layer1_weights(P, lds, lane, wave, bid - fi, G - fi); } } } SEAM(pb + 7);
        if (EN(10) && IN(pb + 8)) { for (int rep = 0; rep < NREP(10); ++rep) { FRESH(); LAYER_PTRS(); if (l == 0) { ctx_gemm_resid<DFF, bf16u, bf16u>((const bf16u*)(ws + WS_ACT), (const bf16u*)(ws + WS_W2), XSC, XSC, mod + 5120 + 2 * NMODV, lds, tid, lane, wave, G, bid); __syncthreads(); }
            pg8::Gemm g{(const bf16u*)(ws + WS_ACT), (const bf16u*)(ws + WS_W2) + (size_t)l * 1024 * DFF, MROWS, DM, DFF}; pg8::OrderX S; S.init(128, DM, G, bid, 1);
            pg8::EpiResid<bf16u, bf16u> E{XSL, XSC, XSL, XSC, mod + 5120};
            pg8::gemm_phase<pg8::EpiResid<bf16u, bf16u>, pg8::OrderX, true, true>(ldsl, g, S, E, tid); } } SEAM(pb + 8);
        }
    { constexpr int l = 1; constexpr int l_ = 1;
        const int pb = 2 + 9 * l; const int skip = l;
#undef LAYER_PTRS
#define LAYER_PTRS() const float* mod = (const float*)(ws + WS_MOD) + (size_t)l * 3 * NMODV; (void)mod; \
        bf16u* XSL = (bf16u*)(ws + WS_XSL); bf16u* XSC = (bf16u*)(ws + WS_XSC); (void)XSL; (void)XSC; bf16u* HN = (bf16u*)(ws + WS_HN); (void)HN;
        if (EN(2) && IN(pb + 0)) { for (int rep = 0; rep < NREP(2); ++rep) { FRESH(); LAYER_PTRS(); phase_norm<bf16u>(XSL, XSC, P.norm1_w + l * DM, mod, 0, 1024, HN, 0, lane, wave, G, bid); } } SEAM(pb + 0);
        if (EN(3) && IN(pb + 1)) { for (int rep = 0; rep < NREP(3); ++rep) { FRESH(); LAYER_PTRS(); pg8::Gemm g{HN, (const bf16u*)(ws + WS_WIN) + (size_t)l * NIN * 1024, MROWS, NIN, DM}; pg8::OrderX S; S.init(MROWS / 256, NIN, G, bid, 0);
            pg8::EpiInProj E{(bf16u*)(ws + WS_U), (float*)(ws + WS_DT)};
            pg8::gemm_phase<pg8::EpiInProj, pg8::OrderX, true, true>(ldsl, g, S, E, tid); } } SEAM(pb + 1);
        if (EN(4) && IN(pb + 2)) { for (int rep = 0; rep < NREP(4); ++rep) { FRESH(); phase_mixprep(P, l, lds, tid, lane, wave, G, bid, rep == NREP(4) - 1); } } SEAM(pb + 2);
        if (EN(5) && IN(pb + 3)) { for (int rep = 0; rep < NREP(5); ++rep) { { FRESH(); for (int _s = 0; _s < SCAN_DUP; ++_s) phase_scan(P, tid, G, bid); } __syncthreads(); { FRESH(); phase_attn(P, l, lds, G, tid, bid); } } } SEAM(pb + 3);
        if (EN(6) && IN(pb + 4)) { for (int rep = 0; rep < NREP(6); ++rep) { FRESH(); phase_ssdout(P, l, lds, tid, lane, wave, G, bid); } } SEAM(pb + 4);
        if (EN(7) && IN(pb + 5)) { for (int rep = 0; rep < NREP(7); ++rep) { FRESH(); LAYER_PTRS(); if (l == 0) { ctx_gemm_resid<DM, bf16u, bf16u>((const bf16u*)(ws + WS_MIX), (const bf16u*)(ws + WS_WOUT), XSC, XSC, mod + 2048 + 2 * NMODV, lds, tid, lane, wave, G, bid); __syncthreads(); }
            pg8::Gemm g{(const bf16u*)(ws + WS_MIX), (const bf16u*)(ws + WS_WOUT) + (size_t)l * 1024 * 1024, MROWS, DM, DM}; pg8::OrderX S; S.init(128, DM, G, bid, 1);
            pg8::EpiResid<bf16u, bf16u> E{XSL, XSC, XSL, XSC, mod + 2048};
            pg8::gemm_phase<pg8::EpiResid<bf16u, bf16u>, pg8::OrderX, true, true>(ldsl, g, S, E, tid); } } SEAM(pb + 5);
        if (EN(8) && IN(pb + 6)) { for (int rep = 0; rep < NREP(8); ++rep) { FRESH(); LAYER_PTRS(); phase_norm<bf16u>(XSL, XSC, P.norm2_w + l * DM, mod, 3072, 4096, HN, skip, lane, wave, G, bid); } } SEAM(pb + 6);
        if (EN(9) && IN(pb + 7)) { for (int rep = 0; rep < NREP(9); ++rep) { FRESH(); LAYER_PTRS(); pg8::Gemm g{HN, (const bf16u*)(ws + WS_W13) + (size_t)l * 2 * DFF * 1024, MROWS, 2 * DFF, DM}; pg8::OrderX S; S.init(skip ? 128 : 130, 2 * DFF, G, bid, skip);
            pg8::EpiSwiGLU E{(bf16u*)(ws + WS_ACT)};
            pg8::gemm_phase<pg8::EpiSwiGLU, pg8::OrderX, true, true>(ldsl, g, S, E, tid);
            if (l == 0) { const int nwg = 130 * 22, R = (nwg + G - 1) / G, fi = nwg - (R - 1) * G;
                if (nwg % G == 0) prep_layer1_weights(P, lds, lane, wave, bid, G); else if (bid >= fi) prep_layer1_weights(P, lds, lane, wave, bid - fi, G - fi); } } } SEAM(pb + 7);
        if (EN(10) && IN(pb + 8)) { for (int rep = 0; rep < NREP(10); ++rep) { FRESH(); LAYER_PTRS(); if (l == 0) { ctx_gemm_resid<DFF, bf16u, bf16u>((const bf16u*)(ws + WS_ACT), (const bf16u*)(ws + WS_W2), XSC, XSC, mod + 5120 + 2 * NMODV, lds, tid, lane, wave, G, bid); __syncthreads(); }
            pg8::Gemm g{(const bf16u*)(ws + WS_ACT), (const bf16u*)(ws + WS_W2) + (size_t)l * 1024 * DFF, MROWS, DM, DFF}; pg8::OrderX S; S.init(128, DM, G, bid, 1);
            pg8::EpiResid<bf16u, float> E{XSL, XSC, P.out, P.out, mod + 5120};
            pg8::gemm_phase<pg8::EpiResid<bf16u, float>, pg8::OrderX, true, true>(ldsl, g, S, E, tid); } } SEAM(pb + 8);
        }
#undef IN
#undef SEAM
}

#ifndef MK_PER_PHASE
#define MK_PER_PHASE 0
#endif
extern "C" void kernel_launch(void* const* d_in, const int* in_sizes, int n_in, void* d_out, int out_size, void* d_ws, size_t ws_size, hipStream_t stream) {
    static int grid = 0;
    if (grid == 0) {
        if (n_in != 23 || in_sizes[0] != NBATCH * LSEQ * DM || out_size != NBATCH * LSEQ * DM || ws_size < WS_END) {
            fprintf(stderr, "kernel_launch: unexpected shapes (n_in %d, in0 %d, out %d, ws %zu)\n", n_in, n_in > 0 ? in_sizes[0] : -1, out_size, ws_size); grid = -1; return; }
        int dev = 0, cus = 0, per_cu = 0;
        (void)hipGetDevice(&dev); (void)hipDeviceGetAttribute(&cus, hipDeviceAttributeMultiprocessorCount, dev);
        if (hipFuncSetAttribute((const void*)hybrid_fwd, hipFuncAttributeMaxDynamicSharedMemorySize, LDS_BYTES) != hipSuccess) { fprintf(stderr, "kernel_launch: hipFuncSetAttribute failed\n"); grid = -1; return; }
        if (hipOccupancyMaxActiveBlocksPerMultiprocessor(&per_cu, (const void*)hybrid_fwd, 512, LDS_BYTES) != hipSuccess || per_cu < 1) { fprintf(stderr, "kernel_launch: occupancy query gives %d\n", per_cu); per_cu = 1; }
        (void)hipGetLastError();
        grid = cus * (per_cu > 1 ? 1 : per_cu);
        if (grid <= 0) grid = 256;
    }
    if (grid < 0) return;
    Params p{};
    const float** pp = (const float**)&p;
    for (int i = 0; i < 23; ++i) pp[i] = (const float*)d_in[i];
    p.out = (float*)d_out; p.ws = (unsigned char*)d_ws;
#if MK_PER_PHASE
    for (int ph = 0; ph < NPHASE; ++ph) { p.ph_lo = ph; p.ph_hi = ph + 1; hipLaunchKernelGGL(hybrid_fwd, dim3(grid), dim3(512), LDS_BYTES, stream, p); }
#else
    p.ph_lo = 0; p.ph_hi = NPHASE;
    void* args[] = {&p};
    hipError_t e = hipLaunchCooperativeKernel((const void*)hybrid_fwd, dim3(grid), dim3(512), args, LDS_BYTES, stream);
    if (e != hipSuccess) fprintf(stderr, "kernel_launch: cooperative launch failed: %s (grid %d)\n", hipGetErrorString(e), grid);
#endif
}
```
